# Optimizing an MI355X kernel written in HIP

```python
import jax, jax.numpy as jnp
from jax import lax
import numpy as np

D_MODEL = 2048
BATCH = 4
SEQ = 4096
DEPTH = 2

N_EVEN = (DEPTH + 1) // 2
N_ODD = DEPTH // 2

HEAD_DIM = 128
NSA_HEADS = D_MODEL // (2 * HEAD_DIM)
NSA_KV_HEADS = max(1, NSA_HEADS // 4)
NSA_GROUP = NSA_HEADS // NSA_KV_HEADS
NSA_WIDTH = NSA_HEADS * HEAD_DIM
KV_WIDTH = NSA_KV_HEADS * HEAD_DIM
N_BRANCH = 3
CMP_BLOCK = 32
CMP_STRIDE = 16
SLC_BLOCK = 64
N_SLC = 16
N_LOCAL_SLC = 2
WINDOW = 512
WIN_Q_BLOCK = 128
SEL_Q_BLOCK = 64
FORCE_SCORE = 1e9

GMLP_GROUP_DIM = 128
GMLP_GROUPS = D_MODEL // (2 * GMLP_GROUP_DIM)
GMLP_WIDTH = GMLP_GROUPS * GMLP_GROUP_DIM
GMLP_CHUNK = 128

EVEN_SPLITS = [NSA_WIDTH] + [KV_WIDTH] * 6 + [N_BRANCH * NSA_HEADS, GMLP_WIDTH, GMLP_WIDTH]
EVEN_IN_WIDTH = sum(EVEN_SPLITS)
MIX_OUT_WIDTH = NSA_WIDTH + GMLP_WIDTH

CONV_WIDTH = 3
SCONV_WIDTH = D_MODEL

D_FF = ((8 * D_MODEL // 3) + 255) // 256 * 256

EPS = 1e-6
NEG = -1e30

kernel_name = "hybrid_nsa_gmlp_shortconv_convffn"


def rms_norm(x, g):
    xf = x.astype(jnp.float32)
    y = xf * lax.rsqrt(jnp.mean(xf * xf, axis=-1, keepdims=True) + EPS)
    return (y * g.astype(jnp.float32)).astype(x.dtype)


def layer_norm(x, g):
    xf = x.astype(jnp.float32)
    xc = xf - jnp.mean(xf, axis=-1, keepdims=True)
    y = xc * lax.rsqrt(jnp.mean(xc * xc, axis=-1, keepdims=True) + EPS)
    return (y * g.astype(jnp.float32)).astype(x.dtype)


def causal_dwconv3(x, w):
    s = x.shape[1]
    xp = jnp.pad(x, ((0, 0), (CONV_WIDTH - 1, 0), (0, 0)))
    return w[0] * xp[:, 0:s] + w[1] * xp[:, 1:s + 1] + w[2] * xp[:, 2:s + 2]


def masked_softmax(s, mask):
    s = jnp.where(mask, s.astype(jnp.float32), NEG)
    m = jnp.max(s, axis=-1, keepdims=True)
    p = jnp.exp(s - m) * mask
    return p / jnp.maximum(jnp.sum(p, axis=-1, keepdims=True), 1e-30)


def nsa_mixer(q, k_cmp, v_cmp, k_slc, v_slc, k_win, v_win, gate_logits,
              q_gain, k_gain, cmp_pe, cmp_k_w1, cmp_k_w2, cmp_v_w1, cmp_v_w2):
    b_, s, _, d = q.shape
    g_, r_ = NSA_KV_HEADS, NSA_GROUP
    pos = jnp.arange(s)
    qg = (rms_norm(q, q_gain) * (d ** -0.5)).reshape(b_, s, g_, r_, d)

    n_cmp = (s - CMP_BLOCK) // CMP_STRIDE + 1
    blk_idx = jnp.arange(n_cmp)[:, None] * CMP_STRIDE + jnp.arange(CMP_BLOCK)[None, :]

    def compress(kv, w1, w2):
        blocks = kv[:, blk_idx] + cmp_pe[:, None, :]
        h = jax.nn.gelu(jnp.einsum('bnlgd,lde->bnge', blocks, w1))
        return jnp.einsum('bnge,ef->bngf', h, w2)

    kc = rms_norm(compress(k_cmp, cmp_k_w1, cmp_k_w2), k_gain[0])
    vc = compress(v_cmp, cmp_v_w1, cmp_v_w2)
    cmp_end = jnp.arange(n_cmp) * CMP_STRIDE + CMP_BLOCK - 1
    cmp_mask = cmp_end[None, :] <= pos[:, None]
    p_cmp = masked_softmax(jnp.einsum('bsgrd,bngd->bgrsn', qg, kc), cmp_mask)
    o_cmp = jnp.einsum('bgrsn,bngd->bsgrd', p_cmp.astype(vc.dtype), vc)

    n_slc = s // SLC_BLOCK
    n_top = min(N_SLC, n_slc)
    cs = jnp.arange(n_cmp) * CMP_STRIDE
    ss = jnp.arange(n_slc) * SLC_BLOCK
    overlap = ((cs[:, None] < ss[None, :] + SLC_BLOCK) &
               (cs[:, None] + CMP_BLOCK > ss[None, :])).astype(jnp.float32)
    imp = jnp.einsum('bgrsn,nj->bgsj', p_cmp, overlap)
    jb = jnp.arange(n_slc)
    cur = pos // SLC_BLOCK
    causal_blk = ss[None, :] <= pos[:, None]
    forced = (jb[None, :] == 0) | ((cur[:, None] - jb[None, :] >= 0) &
                                   (cur[:, None] - jb[None, :] < N_LOCAL_SLC))
    imp = jnp.where(causal_blk, imp, NEG)
    imp = jnp.where(forced, FORCE_SCORE, imp)
    _, sel = lax.top_k(imp, n_top)

    kb = rms_norm(k_slc, k_gain[1]).reshape(b_, n_slc, SLC_BLOCK, g_, d).transpose(0, 3, 1, 2, 4)
    vb = v_slc.reshape(b_, n_slc, SLC_BLOCK, g_, d).transpose(0, 3, 1, 2, 4)
    nq = s // SEL_Q_BLOCK
    q_blocks = qg.reshape(b_, nq, SEL_Q_BLOCK, g_, r_, d).transpose(1, 0, 3, 4, 2, 5)
    sel_blocks = sel.reshape(b_, g_, nq, SEL_Q_BLOCK, n_top).transpose(2, 0, 1, 3, 4)
    bi = jnp.arange(b_)[:, None, None, None]
    gi = jnp.arange(g_)[None, :, None, None]
    n_keys = n_top * SLC_BLOCK

    def sel_block(args):
        qb, idx, start = args
        kg = kb[bi, gi, idx].reshape(b_, g_, SEL_Q_BLOCK, n_keys, d)
        vg = vb[bi, gi, idx].reshape(b_, g_, SEL_Q_BLOCK, n_keys, d)
        kpos = (idx[..., None] * SLC_BLOCK + jnp.arange(SLC_BLOCK)).reshape(b_, g_, SEL_Q_BLOCK, n_keys)
        qpos = start + jnp.arange(SEL_Q_BLOCK)
        mask = kpos[:, :, None] <= qpos[None, None, None, :, None]
        p = masked_softmax(jnp.einsum('bgrqd,bgqkd->bgrqk', qb, kg), mask)
        return jnp.einsum('bgrqk,bgqkd->bgrqd', p.astype(vg.dtype), vg)

    o_slc = lax.map(sel_block, (q_blocks, sel_blocks, jnp.arange(nq) * SEL_Q_BLOCK))
    o_slc = o_slc.transpose(1, 0, 4, 2, 3, 5).reshape(b_, s, g_, r_, d)

    nw = s // WIN_Q_BLOCK
    n_prev = WINDOW // WIN_Q_BLOCK
    kband = (n_prev + 1) * WIN_Q_BLOCK
    pad = ((0, 0), (WINDOW, 0), (0, 0), (0, 0))
    kp = jnp.pad(rms_norm(k_win, k_gain[2]), pad).reshape(b_, nw + n_prev, WIN_Q_BLOCK, g_, d)
    vp = jnp.pad(v_win, pad).reshape(b_, nw + n_prev, WIN_Q_BLOCK, g_, d)
    k_band = jnp.concatenate([kp[:, j:j + nw] for j in range(n_prev + 1)], axis=2)
    v_band = jnp.concatenate([vp[:, j:j + nw] for j in range(n_prev + 1)], axis=2)
    q_w = qg.reshape(b_, nw, WIN_Q_BLOCK, g_, r_, d)
    c0 = jnp.arange(nw)[:, None, None] * WIN_Q_BLOCK
    qpos_w = c0 + jnp.arange(WIN_Q_BLOCK)[None, :, None]
    kpos_w = c0 - WINDOW + jnp.arange(kband)[None, None, :]
    win_mask = (kpos_w >= 0) & (kpos_w <= qpos_w) & (qpos_w - kpos_w < WINDOW)
    p_win = masked_softmax(jnp.einsum('bcqgrd,bckgd->bgrcqk', q_w, k_band), win_mask)
    o_win = jnp.einsum('bgrcqk,bckgd->bcqgrd', p_win.astype(v_band.dtype), v_band).reshape(b_, s, g_, r_, d)

    gates = jax.nn.sigmoid(gate_logits).reshape(b_, s, g_, r_, N_BRANCH)
    o = gates[..., 0:1] * o_cmp + gates[..., 1:2] * o_slc + gates[..., 2:3] * o_win
    return o.reshape(b_, s, NSA_WIDTH)


def gmlp_mixer(uv, v_gain, w_s, b_s):
    b_, s, _ = uv.shape
    z = jax.nn.gelu(uv)
    u, v = z[..., :GMLP_WIDTH], z[..., GMLP_WIDTH:]
    v = layer_norm(v.reshape(b_, s, GMLP_GROUPS, GMLP_GROUP_DIM), v_gain)
    nc = s // GMLP_CHUNK
    vc = v.reshape(b_, nc, GMLP_CHUNK, GMLP_GROUPS, GMLP_GROUP_DIM)
    w = w_s * jnp.tril(jnp.ones((GMLP_CHUNK, GMLP_CHUNK), w_s.dtype))
    mixed = jnp.einsum('gts,bcsgd->bctgd', w, vc) + b_s.T[None, None, :, :, None]
    return u * mixed.reshape(b_, s, GMLP_WIDTH)


def even_mixer(x, norm_g, w_in, q_gain, k_gain, cmp_pe, cmp_k_w1, cmp_k_w2, cmp_v_w1, cmp_v_w2,
               gmlp_norm, gmlp_ws, gmlp_b, w_out):
    b_, s, _ = x.shape
    p = rms_norm(x, norm_g) @ w_in
    q, kc, vc, ks, vs, kw, vw, gl, uv_u, uv_v = jnp.split(p, list(np.cumsum(EVEN_SPLITS)[:-1]), axis=-1)
    kv = lambda t: t.reshape(b_, s, NSA_KV_HEADS, HEAD_DIM)
    o_a = nsa_mixer(q.reshape(b_, s, NSA_HEADS, HEAD_DIM), kv(kc), kv(vc), kv(ks), kv(vs), kv(kw), kv(vw),
                    gl.reshape(b_, s, NSA_HEADS, N_BRANCH), q_gain, k_gain, cmp_pe,
                    cmp_k_w1, cmp_k_w2, cmp_v_w1, cmp_v_w2)
    o_b = gmlp_mixer(jnp.concatenate([uv_u, uv_v], axis=-1), gmlp_norm, gmlp_ws, gmlp_b)
    return jnp.concatenate([o_a, o_b], axis=-1) @ w_out


def odd_mixer(x, norm_g, w_in, conv_w, w_out):
    bg, cg, xt = jnp.split(rms_norm(x, norm_g) @ w_in, 3, axis=-1)
    return (bg * causal_dwconv3(cg * xt, conv_w)) @ w_out


def conv_ffn(x, norm_g, w_in, conv_w, conv_b, w_down):
    g, u = jnp.split(rms_norm(x, norm_g) @ w_in, 2, axis=-1)
    g = causal_dwconv3(g, conv_w) + conv_b
    return (jax.nn.silu(g) * u) @ w_down


def setup_inputs(seed: int = 0) -> dict:
    key = jax.random.key(seed)
    ks = iter(jax.random.split(key, 32))

    def nrm(shape, scale):
        return jax.random.normal(next(ks), shape, jnp.float32) * scale

    def gain(shape):
        return 1.0 + nrm(shape, 0.02)

    d = HEAD_DIM
    return {
        "x": nrm((BATCH, SEQ, D_MODEL), 1.0),
        "ev_norm": gain((N_EVEN, D_MODEL)),
        "ev_w_in": nrm((N_EVEN, D_MODEL, EVEN_IN_WIDTH), D_MODEL ** -0.5),
        "ev_q_gain": gain((N_EVEN, d)),
        "ev_k_gain": gain((N_EVEN, N_BRANCH, d)),
        "ev_cmp_pe": nrm((N_EVEN, CMP_BLOCK, d), 0.2),
        "ev_cmp_k_w1": nrm((N_EVEN, CMP_BLOCK, d, d), (CMP_BLOCK * d) ** -0.5),
        "ev_cmp_k_w2": nrm((N_EVEN, d, d), d ** -0.5),
        "ev_cmp_v_w1": nrm((N_EVEN, CMP_BLOCK, d, d), (CMP_BLOCK * d) ** -0.5),
        "ev_cmp_v_w2": nrm((N_EVEN, d, d), d ** -0.5),
        "ev_gmlp_norm": gain((N_EVEN, GMLP_GROUPS, GMLP_GROUP_DIM)),
        "ev_gmlp_ws": nrm((N_EVEN, GMLP_GROUPS, GMLP_CHUNK, GMLP_CHUNK), 0.5 * GMLP_CHUNK ** -0.5),
        "ev_gmlp_b": gain((N_EVEN, GMLP_GROUPS, GMLP_CHUNK)),
        "ev_w_out": nrm((N_EVEN, MIX_OUT_WIDTH, D_MODEL), MIX_OUT_WIDTH ** -0.5),
        "od_norm": gain((N_ODD, D_MODEL)),
        "od_w_in": nrm((N_ODD, D_MODEL, 3 * SCONV_WIDTH), D_MODEL ** -0.5),
        "od_conv_w": nrm((N_ODD, CONV_WIDTH, SCONV_WIDTH), CONV_WIDTH ** -0.5),
        "od_w_out": nrm((N_ODD, SCONV_WIDTH, D_MODEL), SCONV_WIDTH ** -0.5),
        "ffn_norm": gain((DEPTH, D_MODEL)),
        "ffn_w_in": nrm((DEPTH, D_MODEL, 2 * D_FF), D_MODEL ** -0.5),
        "ffn_conv_w": nrm((DEPTH, CONV_WIDTH, D_FF), CONV_WIDTH ** -0.5),
        "ffn_conv_b": nrm((DEPTH, D_FF), 0.01),
        "ffn_w_down": nrm((DEPTH, D_FF, D_MODEL), D_FF ** -0.5),
    }


def reference(x, ev_norm, ev_w_in, ev_q_gain, ev_k_gain, ev_cmp_pe, ev_cmp_k_w1, ev_cmp_k_w2,
              ev_cmp_v_w1, ev_cmp_v_w2, ev_gmlp_norm, ev_gmlp_ws, ev_gmlp_b, ev_w_out,
              od_norm, od_w_in, od_conv_w, od_w_out,
              ffn_norm, ffn_w_in, ffn_conv_w, ffn_conv_b, ffn_w_down):
    for i in range(DEPTH):
        j = i // 2
        if i % 2 == 0:
            x = x + even_mixer(x, ev_norm[j], ev_w_in[j], ev_q_gain[j], ev_k_gain[j], ev_cmp_pe[j],
                               ev_cmp_k_w1[j], ev_cmp_k_w2[j], ev_cmp_v_w1[j], ev_cmp_v_w2[j],
                               ev_gmlp_norm[j], ev_gmlp_ws[j], ev_gmlp_b[j], ev_w_out[j])
        else:
            x = x + odd_mixer(x, od_norm[j], od_w_in[j], od_conv_w[j], od_w_out[j])
        x = x + conv_ffn(x, ffn_norm[i], ffn_w_in[i], ffn_conv_w[i], ffn_conv_b[i], ffn_w_down[i])
    return x
```

```cpp
#include <hip/hip_runtime.h>
#include <hip/hip_cooperative_groups.h>
#include <cstdio>
namespace cg = cooperative_groups;

#ifndef MULTI_LAUNCH
#define MULTI_LAUNCH 0
#endif

#define DI __device__ __forceinline__
#define LAS __attribute__((address_space(3)))
typedef unsigned short bf16_t;
typedef short bf16x8 __attribute__((ext_vector_type(8)));
typedef float f32x2 __attribute__((ext_vector_type(2)));
typedef float f32x4 __attribute__((ext_vector_type(4)));
typedef float f32x16 __attribute__((ext_vector_type(16)));
typedef unsigned u32x2 __attribute__((ext_vector_type(2)));
typedef unsigned u32x4 __attribute__((ext_vector_type(4)));
typedef __bf16 bf16v2 __attribute__((ext_vector_type(2)));

constexpr int NTOK = 16384, DM = 2048, SEQ = 4096, LDP = 4864, DFF = 5632, NFF2 = 11264;
constexpr int LDS_BYTES = 131072 + 256;
constexpr int NPHASE = 14;
constexpr float EPSF = 1e-6f;
constexpr float NEGF = -1e30f;

constexpr size_t XCD_BAR_WORDS_C = 3456;
constexpr size_t OFF_bar = 0;
constexpr size_t END_bar = OFF_bar + (XCD_BAR_WORDS_C * 4);
constexpr size_t OFF_wt_ev_in = END_bar;
constexpr size_t END_wt_ev_in = OFF_wt_ev_in + ((size_t)LDP * DM * 2);
constexpr size_t OFF_wt_ev_out = END_wt_ev_in;
constexpr size_t END_wt_ev_out = OFF_wt_ev_out + ((size_t)DM * DM * 2);
constexpr size_t OFF_wt_ffn_in = END_wt_ev_out;
constexpr size_t END_wt_ffn_in = OFF_wt_ffn_in + ((size_t)2 * NFF2 * DM * 2);
constexpr size_t OFF_wt_ffn_dn = END_wt_ffn_in;
constexpr size_t END_wt_ffn_dn = OFF_wt_ffn_dn + ((size_t)2 * DM * DFF * 2);
constexpr size_t OFF_wt_od_in = END_wt_ffn_dn;
constexpr size_t END_wt_od_in = OFF_wt_od_in + ((size_t)6144 * DM * 2);
constexpr size_t OFF_wt_od_out = END_wt_od_in;
constexpr size_t END_wt_od_out = OFF_wt_od_out + ((size_t)DM * DM * 2);
constexpr size_t OFF_w1t_k = END_wt_od_out;
constexpr size_t END_w1t_k = OFF_w1t_k + ((size_t)128 * 4096 * 2);
constexpr size_t OFF_w1t_v = END_w1t_k;
constexpr size_t END_w1t_v = OFF_w1t_v + ((size_t)128 * 4096 * 2);
constexpr size_t OFF_xb = END_w1t_v;
constexpr size_t END_xb = OFF_xb + ((size_t)NTOK * DM * 2);
constexpr size_t OFF_ssq = END_xb;
constexpr size_t END_ssq = OFF_ssq + ((size_t)4 * NTOK * 32 * 4);
constexpr size_t OFF_REGION = END_ssq;
constexpr size_t OFF_P = OFF_REGION;
constexpr size_t END_P = OFF_P + ((size_t)NTOK * LDP * 2);
constexpr size_t OFF_qn = END_P;
constexpr size_t END_qn = OFF_qn + ((size_t)NTOK * 1024 * 2);
constexpr size_t OFF_ksn = END_qn;
constexpr size_t END_ksn = OFF_ksn + ((size_t)NTOK * 256 * 2);
constexpr size_t OFF_kwn = END_ksn;
constexpr size_t END_kwn = OFF_kwn + ((size_t)NTOK * 256 * 2);
constexpr size_t OFF_vsT = END_kwn;
constexpr size_t END_vsT = OFF_vsT + ((size_t)NTOK * 256 * 2);
constexpr size_t OFF_vwT = END_vsT;
constexpr size_t END_vwT = OFF_vwT + ((size_t)NTOK * 256 * 2);
constexpr size_t OFF_kcn = END_vwT;
constexpr size_t END_kcn = OFF_kcn + ((size_t)8 * 256 * 128 * 2);
constexpr size_t OFF_vcT = END_kcn;
constexpr size_t END_vcT = OFF_vcT + ((size_t)8 * 128 * 256 * 2);
constexpr size_t OFF_oacc = END_vcT;
constexpr size_t END_oacc = OFF_oacc + ((size_t)NTOK * 1024 * 4);
constexpr size_t OFF_omix = END_oacc;
constexpr size_t END_omix = OFF_omix + ((size_t)NTOK * DM * 2);
constexpr size_t OFF_H = OFF_REGION;
constexpr size_t END_H = OFF_H + ((size_t)NTOK * DFF * 2);
constexpr size_t OFF_tailG = END_H;
constexpr size_t END_tailG = OFF_tailG + ((size_t)512 * DFF * 4);
constexpr size_t OFF_headA = END_tailG;
constexpr size_t END_headA = OFF_headA + ((size_t)512 * DFF * 4);
constexpr size_t OFF_headU = END_headA;
constexpr size_t END_headU = OFF_headU + ((size_t)512 * DFF * 4);
constexpr size_t OFF_BG = OFF_REGION;
constexpr size_t END_BG = OFF_BG + ((size_t)NTOK * DM * 2);
constexpr size_t OFF_Cc = END_BG;
constexpr size_t END_Cc = OFF_Cc + ((size_t)NTOK * DM * 2);
constexpr size_t OFF_A6 = END_Cc;
constexpr size_t END_A6 = OFF_A6 + ((size_t)NTOK * DM * 2);
constexpr size_t OFF_tailM = END_A6;
constexpr size_t END_tailM = OFF_tailM + ((size_t)512 * DM * 4);
constexpr size_t OFF_headC = END_tailM;
constexpr size_t END_headC = OFF_headC + ((size_t)512 * DM * 4);
constexpr size_t WS_NEED = (END_omix > END_headU ? (END_omix > END_headC ? END_omix : END_headC) : (END_headU > END_headC ? END_headU : END_headC));
struct Params {
  const float *x, *ev_norm, *ev_w_in, *ev_q_gain, *ev_k_gain, *ev_cmp_pe, *ev_cmp_k_w1, *ev_cmp_k_w2, *ev_cmp_v_w1, *ev_cmp_v_w2,
      *ev_gmlp_norm, *ev_gmlp_ws, *ev_gmlp_b, *ev_w_out, *od_norm, *od_w_in, *od_conv_w, *od_w_out, *ffn_norm, *ffn_w_in, *ffn_conv_w,
      *ffn_conv_b, *ffn_w_down;
  float* out;
  unsigned char* ws;
  int phase_lo, phase_hi;
};

DI float bf2f(unsigned b) { return __uint_as_float(b << 16); }
DI unsigned pack2(float lo, float hi) { f32x2 v = {lo, hi}; bf16v2 r = __builtin_convertvector(v, bf16v2); return __builtin_bit_cast(unsigned, r); }
DI float lo_f(unsigned w) { return __uint_as_float(w << 16); }
DI float hi_f(unsigned w) { return __uint_as_float(w & 0xffff0000u); }
DI float sigmoid_f(float x) { return __builtin_amdgcn_rcpf(1.0f + __builtin_amdgcn_exp2f(x * -1.4426950408889634f)); }
DI float gelu_tanh(float x) { const float u = 1.5957691216057308f * (x + 0.044715f * x * x * x); return x * sigmoid_f(u); }
DI float silu_f(float x) { return x * sigmoid_f(x); }
#define MFMA32(a, b, c) __builtin_amdgcn_mfma_f32_32x32x16_bf16((a), (b), (c), 0, 0, 0)

namespace pg8 {
constexpr int BM = 256, BK = 64, HALF = 128, HTB = HALF * BK * 2, NXCD = 8, WGM = 8;
DI int lds_byte(int r, int c) { const int st = (r >> 4) * 2 + (c >> 5), rr = r & 15, cc = c & 31, ob = rr * 64 + cc * 2; return st * 1024 + (ob ^ (((ob >> 9) & 1) << 5)); }
DI void stage_rc(int b, int& R, int& C) { const int st = b / 1024, sb = b % 1024, swz = sb ^ (((sb >> 9) & 1) << 5); R = (st >> 1) * 16 + swz / 64; C = (st & 1) * 32 + (swz % 64) / 2; }
DI int perm32(int rho) { const int n = rho >> 4, i = rho & 15; return 8 * (i >> 2) + 4 * n + (i & 3); }
struct Unit { int pm, pn; };
struct Gemm { const bf16_t* A; const bf16_t* Bt; int M, N, K; };
struct StaticOrder {
  int nM, nN, nwg, G, c;
  DI void init(int M, int N, int G_, int c_) { nM = M / BM; nN = N / BM; nwg = nM * nN; G = G_; c = c_; }
  DI bool next(int i, Unit& u) const {
    const long L = (long)i * G + c; if (L >= nwg) return false;
    int wgid = (int)L; { const int q = nwg / NXCD, r = nwg % NXCD, xcd = wgid % NXCD, off = wgid / NXCD; wgid = (xcd < r ? xcd * (q + 1) : r * (q + 1) + (xcd - r) * q) + off; }
    const int nig = WGM * nN, gid = wgid / nig, fm = gid * WGM, gsz = (nM - fm) < WGM ? (nM - fm) : WGM;
    u.pm = fm + ((wgid % nig) % gsz); u.pn = (wgid % nig) / gsz; return true;
  }
};
struct TripletOrder {
  int G, c;
  DI void init(int G_, int c_) { G = G_; c = c_; }
  DI bool next(int i, Unit& u) const {
    const int rd = i / 3, k = i - 3 * rd;
    const int tr = c + G * rd; if (tr >= 512) return false;
    int pm, t;
    if (G == 256) { const int x = c & 7, q = (c >> 3) + 32 * rd; pm = 8 * x + (q & 7); t = q >> 3; }
    else { pm = tr >> 3; t = tr & 7; }
    u.pm = pm; u.pn = k < 2 ? 2 * t + k : 16 + t; return true;
  }
};
DI float row_rstd(const float* ssq, int row, int fq) {
  const f32x4 a = *(const f32x4*)(ssq + (size_t)row * 32 + fq * 8), b = *(const f32x4*)(ssq + (size_t)row * 32 + fq * 8 + 4);
  float sm = ((a[0] + a[1]) + (a[2] + a[3])) + ((b[0] + b[1]) + (b[2] + b[3]));
  sm += __shfl_xor(sm, 16); sm += __shfl_xor(sm, 32);
  return rsqrtf(sm * (1.0f / 2048.f) + 1e-6f);
}
struct EpiResid {
  static constexpr bool PERM = true;
  float* C; const float* base; bf16_t* xb; float* ssq;
  DI void operator()(const f32x4 (&acc)[2][2][4][2], const Unit& u, int wr, int wc, int fr, int fq) const {
    const int row0 = u.pm * BM + wr * 64 + fr, col0 = u.pn * BM + wc * 32 + 8 * fq;
#pragma unroll
    for (int ai = 0; ai < 2; ++ai) {
      f32x4 bv[4][2][2];
#pragma unroll
      for (int m = 0; m < 4; ++m)
#pragma unroll
        for (int bj = 0; bj < 2; ++bj) {
          const float* bp = base + (size_t)(row0 + ai * HALF + m * 16) * 2048 + col0 + bj * HALF;
          bv[m][bj][0] = *(const f32x4*)bp; bv[m][bj][1] = *(const f32x4*)(bp + 4);
        }
#pragma unroll
      for (int m = 0; m < 4; ++m) {
        const int row = row0 + ai * HALF + m * 16;
        const size_t off = (size_t)row * 2048 + col0;
        float ss = 0.f;
#pragma unroll
        for (int bj = 0; bj < 2; ++bj) {
          const f32x4 v0 = acc[ai][bj][m][0] + bv[m][bj][0], v1 = acc[ai][bj][m][1] + bv[m][bj][1];
          *(f32x4*)(C + off + bj * HALF) = v0; *(f32x4*)(C + off + bj * HALF + 4) = v1;
          if (xb) {
            u32x4 w; w.x = pack2(v0[0], v0[1]); w.y = pack2(v0[2], v0[3]); w.z = pack2(v1[0], v1[1]); w.w = pack2(v1[2], v1[3]);
            *(u32x4*)(xb + off + bj * HALF) = w;
            ss += v0[0] * v0[0] + v0[1] * v0[1] + v0[2] * v0[2] + v0[3] * v0[3] + v1[0] * v1[0] + v1[1] * v1[1] + v1[2] * v1[2] + v1[3] * v1[3];
          }
        }
        if (xb) {
          ss += __shfl_xor(ss, 16); ss += __shfl_xor(ss, 32);
          if (fq == 0) ssq[(size_t)row * 32 + u.pn * 4 + wc] = ss;
        }
      }
    }
  }
};
struct EpiBf16 {
  static constexpr bool PERM = true;
  bf16_t* O; int ldc; const float* ssq;
  DI void operator()(const f32x4 (&acc)[2][2][4][2], const Unit& u, int wr, int wc, int fr, int fq) const {
    const int row0 = u.pm * BM + wr * 64 + fr, col0 = u.pn * BM + wc * 32 + 8 * fq;
    float rsv[2][4];
#pragma unroll
    for (int ai = 0; ai < 2; ++ai)
#pragma unroll
      for (int m = 0; m < 4; ++m) rsv[ai][m] = row_rstd(ssq, row0 + ai * HALF + m * 16, fq);
#pragma unroll
    for (int ai = 0; ai < 2; ++ai)
#pragma unroll
      for (int m = 0; m < 4; ++m) {
        const int row = row0 + ai * HALF + m * 16;
        const float rs = rsv[ai][m];
        bf16_t* rowp = O + (size_t)row * ldc + col0;
#pragma unroll
        for (int bj = 0; bj < 2; ++bj) {
          const f32x4 v0 = acc[ai][bj][m][0] * rs, v1 = acc[ai][bj][m][1] * rs;
          u32x4 w; w.x = pack2(v0[0], v0[1]); w.y = pack2(v0[2], v0[3]); w.z = pack2(v1[0], v1[1]); w.w = pack2(v1[2], v1[3]);
          *(u32x4*)(rowp + bj * HALF) = w;
        }
      }
  }
};

DI float dpp_ror1(float v) { return __int_as_float(__builtin_amdgcn_update_dpp(0, __float_as_int(v), 0x121, 0xf, 0xf, false)); }
DI float dpp_ror2(float v) { return __int_as_float(__builtin_amdgcn_update_dpp(0, __float_as_int(v), 0x122, 0xf, 0xf, false)); }
struct EpiFfn {
  static constexpr bool PERM = true;
  bf16_t* H; const float* cw; const float* cb; float* tailG; float* headA; float* headU; const float* ssq;
  DI void operator()(const f32x4 (&acc)[2][2][4][2], const Unit& u, int wr, int wc, int fr, int fq) const {
    const int col = u.pn * 128 + wc * 32 + 8 * fq;
    float w0[8], w1[8], w2[8], bb[8];
#pragma unroll
    for (int e = 0; e < 8; ++e) { w0[e] = cw[col + e]; w1[e] = cw[5632 + col + e]; w2[e] = cw[2 * 5632 + col + e]; bb[e] = cb[col + e]; }
#pragma unroll
    for (int ai = 0; ai < 2; ++ai) {
      const int row0 = u.pm * BM + ai * HALF + wr * 64, span = row0 >> 6;
      float rsv[4];
#pragma unroll
      for (int m = 0; m < 4; ++m) rsv[m] = row_rstd(ssq, row0 + 16 * m + fr, fq);
      float p1[8], p2[8];
#pragma unroll
      for (int e = 0; e < 8; ++e) { p1[e] = 0.f; p2[e] = 0.f; }
#pragma unroll
      for (int m = 0; m < 4; ++m) {
        float g[8], uu[8], a[8];
        const float rs = rsv[m];
#pragma unroll
        for (int e = 0; e < 4; ++e) { g[e] = acc[ai][0][m][0][e] * rs; g[4 + e] = acc[ai][0][m][1][e] * rs; uu[e] = acc[ai][1][m][0][e] * rs; uu[4 + e] = acc[ai][1][m][1][e] * rs; }
#pragma unroll
        for (int e = 0; e < 8; ++e) {
          const float x1 = dpp_ror1(g[e]), x2 = dpp_ror2(g[e]);
          const float pr1 = (fr == 0) ? p1[e] : x1, pr2 = (fr < 2) ? p2[e] : x2;
          a[e] = w2[e] * g[e] + w1[e] * pr1 + w0[e] * pr2 + bb[e];
          p1[e] = x1; p2[e] = x2;
        }
        if (m == 0 && fr < 2) {
          float* ha = headA + (size_t)(span * 2 + fr) * 5632 + col; float* hu = headU + (size_t)(span * 2 + fr) * 5632 + col;
          *(f32x4*)ha = (f32x4){a[0], a[1], a[2], a[3]}; *(f32x4*)(ha + 4) = (f32x4){a[4], a[5], a[6], a[7]};
          *(f32x4*)hu = (f32x4){uu[0], uu[1], uu[2], uu[3]}; *(f32x4*)(hu + 4) = (f32x4){uu[4], uu[5], uu[6], uu[7]};
        } else {
          u32x4 w;
          w.x = pack2(silu_f(a[0]) * uu[0], silu_f(a[1]) * uu[1]);
          w.y = pack2(silu_f(a[2]) * uu[2], silu_f(a[3]) * uu[3]);
          w.z = pack2(silu_f(a[4]) * uu[4], silu_f(a[5]) * uu[5]);
          w.w = pack2(silu_f(a[6]) * uu[6], silu_f(a[7]) * uu[7]);
          *(u32x4*)(H + (size_t)(row0 + 16 * m + fr) * 5632 + col) = w;
        }
        if (m == 3 && fr >= 14) {
          float* tg = tailG + (size_t)(span * 2 + fr - 14) * 5632 + col;
          *(f32x4*)tg = (f32x4){g[0], g[1], g[2], g[3]}; *(f32x4*)(tg + 4) = (f32x4){g[4], g[5], g[6], g[7]};
        }
      }
    }
  }
};

struct EpiOdd {
  static constexpr bool PERM = true;
  bf16_t* BG; bf16_t* C; const float* cw; float* tailM; float* headC; const float* ssq;
  DI void operator()(const f32x4 (&acc)[2][2][4][2], const Unit& u, int wr, int wc, int fr, int fq) const {
    if (u.pn >= 16) {
      const int row0 = u.pm * BM + wr * 64 + fr, col0 = (u.pn - 16) * BM + wc * 32 + 8 * fq;
#pragma unroll
      for (int ai = 0; ai < 2; ++ai) {
#pragma unroll
        for (int mh = 0; mh < 2; ++mh) {
          u32x4 cw4[2][2];
          asm volatile("" ::: "memory");
#pragma unroll
          for (int mm = 0; mm < 2; ++mm) {
            const bf16_t* cp = C + (size_t)(row0 + ai * HALF + (2 * mh + mm) * 16) * 2048 + col0;
            cw4[mm][0] = *(const u32x4*)cp; cw4[mm][1] = *(const u32x4*)(cp + HALF);
          }
#pragma unroll
          for (int mm = 0; mm < 2; ++mm) {
            const int m = 2 * mh + mm;
            const bool head = (m == 0) && (fr < 2);
            bf16_t* rowp = BG + (size_t)(row0 + ai * HALF + m * 16) * 2048 + col0;
#pragma unroll
            for (int bj = 0; bj < 2; ++bj) {
              const u32x4 cw = cw4[mm][bj];
              const float c0 = head ? 1.f : lo_f(cw.x), c1 = head ? 1.f : hi_f(cw.x), c2 = head ? 1.f : lo_f(cw.y), c3 = head ? 1.f : hi_f(cw.y);
              const float c4 = head ? 1.f : lo_f(cw.z), c5 = head ? 1.f : hi_f(cw.z), c6 = head ? 1.f : lo_f(cw.w), c7 = head ? 1.f : hi_f(cw.w);
              const f32x4 v0 = acc[ai][bj][m][0], v1 = acc[ai][bj][m][1];
              u32x4 w; w.x = pack2(v0[0] * c0, v0[1] * c1); w.y = pack2(v0[2] * c2, v0[3] * c3); w.z = pack2(v1[0] * c4, v1[1] * c5); w.w = pack2(v1[2] * c6, v1[3] * c7);
              *(u32x4*)(rowp + bj * HALF) = w;
            }
          }
        }
      }
      return;
    }
    const int col = u.pn * 128 + wc * 32 + 8 * fq;
    float w0[8], w1[8], w2[8];
#pragma unroll
    for (int e = 0; e < 8; ++e) { w0[e] = cw[col + e]; w1[e] = cw[2048 + col + e]; w2[e] = cw[4096 + col + e]; }
#pragma unroll
    for (int ai = 0; ai < 2; ++ai) {
      const int row0 = u.pm * BM + ai * HALF + wr * 64, span = row0 >> 6;
      float rsv[4];
#pragma unroll
      for (int m = 0; m < 4; ++m) rsv[m] = row_rstd(ssq, row0 + 16 * m + fr, fq);
      float p1[8], p2[8];
#pragma unroll
      for (int e = 0; e < 8; ++e) { p1[e] = 0.f; p2[e] = 0.f; }
#pragma unroll
      for (int m = 0; m < 4; ++m) {
        float g[8], a[8];
        const float rs1 = rsv[m], rs2 = rs1 * rs1;
#pragma unroll
        for (int e = 0; e < 4; ++e) { g[e] = acc[ai][0][m][0][e] * acc[ai][1][m][0][e] * rs2; g[4 + e] = acc[ai][0][m][1][e] * acc[ai][1][m][1][e] * rs2; }
#pragma unroll
        for (int e = 0; e < 8; ++e) {
          const float x1 = dpp_ror1(g[e]), x2 = dpp_ror2(g[e]);
          const float pr1 = (fr == 0) ? p1[e] : x1, pr2 = (fr < 2) ? p2[e] : x2;
          a[e] = w2[e] * g[e] + w1[e] * pr1 + w0[e] * pr2;
          p1[e] = x1; p2[e] = x2;
        }
        if (m == 0 && fr < 2) {
          float* hc = headC + (size_t)(span * 2 + fr) * 2048 + col;
          *(f32x4*)hc = (f32x4){a[0], a[1], a[2], a[3]}; *(f32x4*)(hc + 4) = (f32x4){a[4], a[5], a[6], a[7]};
        } else {
          u32x4 w; w.x = pack2(a[0] * rs1, a[1] * rs1); w.y = pack2(a[2] * rs1, a[3] * rs1); w.z = pack2(a[4] * rs1, a[5] * rs1); w.w = pack2(a[6] * rs1, a[7] * rs1);
          *(u32x4*)(C + (size_t)(row0 + 16 * m + fr) * 2048 + col) = w;
        }
        if (m == 3 && fr >= 14) {
          float* tg = tailM + (size_t)(span * 2 + fr - 14) * 2048 + col;
          *(f32x4*)tg = (f32x4){g[0], g[1], g[2], g[3]}; *(f32x4*)(tg + 4) = (f32x4){g[4], g[5], g[6], g[7]};
        }
      }
    }
  }
};

template <class Epi, class Sched = StaticOrder>
DI void gemm_phase(LAS unsigned char* lds, const Gemm g, const Sched& S, const Epi& E) {
  const int tid = threadIdx.x, wid = __builtin_amdgcn_readfirstlane(tid >> 6), lane = tid & 63, wr = wid >> 2, wc = wid & 3, fr = lane & 15, fq = lane >> 4;
  const int K = g.K, nt = K / BK;
  unsigned voffA[2], voffB[2];
#pragma unroll
  for (int i = 0; i < 2; ++i) { int R, C; stage_rc(tid * 16 + i * 8192, R, C); const int Rb = Epi::PERM ? ((R & ~31) + perm32(R & 31)) : R;
    voffA[i] = (unsigned)(R * K + C) * 2u; voffB[i] = (unsigned)(Rb * K + C) * 2u; }
  const size_t kstep = (size_t)(BK * 2);
  const size_t hstep = (size_t)HALF * K * 2;
  const size_t tstep = 2 * hstep;
  const unsigned ldsw = (unsigned)wid * 1024u;
  const int aoff = lds_byte(wr * 64 + fr, fq * 8), boff = lds_byte(wc * 32 + fr, fq * 8);
#define PG8_SA(b, h) (((b) * 2 + (h)) * HTB)
#define PG8_SB(b, h) ((4 + (b) * 2 + (h)) * HTB)
#define PG8_STAGE(bufoff, gbase, voff) do { _Pragma("unroll") for (int _i = 0; _i < 2; ++_i) \
    __builtin_amdgcn_global_load_lds((const unsigned*)((const char*)(gbase) + (voff)[_i]), (LAS unsigned*)(lds + (bufoff) + ldsw + _i * 8192), 16, 0, 0); } while (0)
#define PG8_LDA(dst, b, h) do { _Pragma("unroll") for (int m = 0; m < 4; ++m) _Pragma("unroll") for (int k = 0; k < 2; ++k) dst[m][k] = *(const LAS bf16x8*)(lds + PG8_SA(b, h) + aoff + m * 2048 + k * 1024); } while (0)
#define PG8_LDB(dst, b, h) do { _Pragma("unroll") for (int n = 0; n < 2; ++n) _Pragma("unroll") for (int k = 0; k < 2; ++k) dst[n][k] = *(const LAS bf16x8*)(lds + PG8_SB(b, h) + boff + n * 2048 + k * 1024); } while (0)
#define PG8_MMA(ai, bj, At, Bt) do { __builtin_amdgcn_s_setprio(1); _Pragma("unroll") for (int m = 0; m < 4; ++m) _Pragma("unroll") for (int n = 0; n < 2; ++n) _Pragma("unroll") for (int k = 0; k < 2; ++k) \
    acc[ai][bj][m][n] = __builtin_amdgcn_mfma_f32_16x16x32_bf16(Bt[n][k], At[m][k], acc[ai][bj][m][n], 0, 0, 0); __builtin_amdgcn_s_setprio(0); } while (0)
#define PG8_WAIT_V(n) asm volatile("s_waitcnt vmcnt(" #n ")" ::: "memory")
#define PG8_WAIT_L(n) asm volatile("s_waitcnt lgkmcnt(" #n ")" ::: "memory")
#define PG8_BAR __builtin_amdgcn_s_barrier()
#define PG8_SCHED __builtin_amdgcn_sched_barrier(0)
  Unit cur, nxt; int ui = 0;
  if (!S.next(0, cur)) return;
  f32x4 acc[2][2][4][2];
#pragma unroll
  for (int a = 0; a < 2; ++a)
#pragma unroll
    for (int b = 0; b < 2; ++b)
#pragma unroll
      for (int m = 0; m < 4; ++m)
#pragma unroll
        for (int n = 0; n < 2; ++n) acc[a][b][m][n] = (f32x4){0.f, 0.f, 0.f, 0.f};
  bf16x8 At[4][2], B0[2][2], B1[2][2];
  const char* cA = (const char*)g.A + (size_t)cur.pm * tstep; const char* cB = (const char*)g.Bt + (size_t)cur.pn * tstep;
  PG8_STAGE(PG8_SB(0, 0), cB, voffB); PG8_STAGE(PG8_SA(0, 0), cA, voffA); PG8_STAGE(PG8_SB(0, 1), cB + hstep, voffB); PG8_STAGE(PG8_SA(0, 1), cA + hstep, voffA);
  if (wr == 1) PG8_BAR;
  PG8_WAIT_V(4); PG8_BAR;
  PG8_STAGE(PG8_SB(1, 0), cB + kstep, voffB); PG8_STAGE(PG8_SA(1, 0), cA + kstep, voffA); PG8_STAGE(PG8_SB(1, 1), cB + hstep + kstep, voffB);
  PG8_WAIT_V(6); PG8_BAR;
  for (;;) {
    const bool has_next = S.next(ui + 1, nxt);
    const char* nA = has_next ? (const char*)g.A + (size_t)nxt.pm * tstep : cA; const char* nB = has_next ? (const char*)g.Bt + (size_t)nxt.pn * tstep : cB;
    for (int t = 0; t < nt; t += 2) {
      const bool last = (t == nt - 2);
      const char* a1 = cA + (size_t)(t + 1) * kstep;
      const char* a2 = last ? nA : cA + (size_t)(t + 2) * kstep; const char* b2 = last ? nB : cB + (size_t)(t + 2) * kstep;
      const char* a3 = a2 + kstep; const char* b3 = b2 + kstep;
      PG8_LDB(B0, 0, 0); PG8_SCHED; PG8_LDA(At, 0, 0); PG8_STAGE(PG8_SA(1, 1), a1 + hstep, voffA);
      PG8_WAIT_L(8); PG8_BAR; PG8_WAIT_L(0); PG8_MMA(0, 0, At, B0); PG8_BAR; PG8_SCHED;
      PG8_LDB(B1, 0, 1); PG8_STAGE(PG8_SB(0, 0), b2, voffB);
      PG8_BAR; PG8_WAIT_L(0); PG8_MMA(0, 1, At, B1); PG8_BAR;
      PG8_LDA(At, 0, 1); PG8_STAGE(PG8_SA(0, 0), a2, voffA);
      PG8_BAR; PG8_WAIT_L(0); PG8_MMA(1, 0, At, B0); PG8_BAR; PG8_SCHED;
      PG8_STAGE(PG8_SB(0, 1), b2 + hstep, voffB);
      PG8_WAIT_V(6); PG8_BAR; PG8_MMA(1, 1, At, B1); PG8_BAR;
      PG8_LDB(B0, 1, 0); PG8_SCHED; PG8_LDA(At, 1, 0); PG8_STAGE(PG8_SA(0, 1), a2 + hstep, voffA);
      PG8_WAIT_L(8); PG8_BAR; PG8_WAIT_L(0); PG8_MMA(0, 0, At, B0); PG8_BAR; PG8_SCHED;
      PG8_LDB(B1, 1, 1); PG8_STAGE(PG8_SB(1, 0), b3, voffB);
      PG8_BAR; PG8_WAIT_L(0); PG8_MMA(0, 1, At, B1); PG8_BAR;
      PG8_LDA(At, 1, 1); PG8_STAGE(PG8_SA(1, 0), a3, voffA);
      PG8_BAR; PG8_WAIT_L(0); PG8_MMA(1, 0, At, B0); PG8_BAR; PG8_SCHED;
      PG8_STAGE(PG8_SB(1, 1), b3 + hstep, voffB);
      PG8_WAIT_V(6); PG8_BAR; PG8_MMA(1, 1, At, B1); PG8_BAR;
    }
    E(acc, cur, wr, wc, fr, fq);
    if (!has_next) break;
#pragma unroll
    for (int a = 0; a < 2; ++a)
#pragma unroll
      for (int b = 0; b < 2; ++b)
#pragma unroll
        for (int m = 0; m < 4; ++m)
#pragma unroll
          for (int n = 0; n < 2; ++n) acc[a][b][m][n] = (f32x4){0.f, 0.f, 0.f, 0.f};
    cur = nxt; cA = nA; cB = nB; ++ui;
  }
  PG8_WAIT_V(0);
  if (wr == 0) PG8_BAR;
  PG8_BAR;
#undef PG8_SA
#undef PG8_SB
#undef PG8_STAGE
#undef PG8_LDA
#undef PG8_LDB
#undef PG8_MMA
#undef PG8_WAIT_V
#undef PG8_WAIT_L
#undef PG8_BAR
#undef PG8_SCHED
}
}

struct CJob { const float* src; bf16_t* dst; int K, N, Nout, kind; const float* gain; };
DI CJob get_job(const Params& p, int j) {
  CJob c;
  switch (j) {
    case 0: c = {p.ev_w_in, ((bf16_t*)(p.ws + OFF_wt_ev_in)), 2048, 4632, 4864, 1, p.ev_norm}; break;
    case 1: c = {p.ev_w_out, ((bf16_t*)(p.ws + OFF_wt_ev_out)), 2048, 2048, 2048, 0, nullptr}; break;
    case 2: c = {p.ffn_w_in, ((bf16_t*)(p.ws + OFF_wt_ffn_in)), 2048, NFF2, NFF2, 2, p.ffn_norm}; break;
    case 3: c = {p.ffn_w_in + (size_t)2048 * NFF2, ((bf16_t*)(p.ws + OFF_wt_ffn_in)) + (size_t)NFF2 * 2048, 2048, NFF2, NFF2, 2, p.ffn_norm + 2048}; break;
    case 4: c = {p.ffn_w_down, ((bf16_t*)(p.ws + OFF_wt_ffn_dn)), DFF, 2048, 2048, 0, nullptr}; break;
    case 5: c = {p.ffn_w_down + (size_t)DFF * 2048, ((bf16_t*)(p.ws + OFF_wt_ffn_dn)) + (size_t)2048 * DFF, DFF, 2048, 2048, 0, nullptr}; break;
    case 6: c = {p.od_w_in, ((bf16_t*)(p.ws + OFF_wt_od_in)), 2048, 6144, 6144, 3, p.od_norm}; break;
    case 7: c = {p.od_w_out, ((bf16_t*)(p.ws + OFF_wt_od_out)), 2048, 2048, 2048, 0, nullptr}; break;
    case 8: c = {p.ev_cmp_k_w1, ((bf16_t*)(p.ws + OFF_w1t_k)), 4096, 128, 128, 0, nullptr}; break;
    default: c = {p.ev_cmp_v_w1, ((bf16_t*)(p.ws + OFF_w1t_v)), 4096, 128, 128, 0, nullptr}; break;
  }
  return c;
}
DI int map_col(int kind, int n) {
  if (kind == 0) return n;
  if (kind == 1) return n < 2560 ? n : (n < 4608 ? n + 24 : (n < 4632 ? n - 2048 : -1));
  const int T = n >> 8, c = n & 255;
  if (kind == 3) return T < 16 ? (c < 128 ? 2048 + 128 * T + c : 4096 + 128 * T + (c - 128)) : 256 * (T - 16) + c;
  return c < 128 ? 128 * T + c : DFF + 128 * T + (c - 128);
}
DI void conv_phase(const Params& p, unsigned char* smem) {
  float* tile = (float*)smem;
  const int tid = threadIdx.x;
  int cum = 0;
  for (int j = 0; j < 10; ++j) {
    const CJob jb = get_job(p, j);
    const int ntn = jb.Nout / 256, ngroups = (jb.K / 64) * ntn;
    const int G_ = (int)gridDim.x, first = ((int)blockIdx.x - (cum % G_) + G_) % G_;
    cum += (ntn == 0) ? jb.K / 64 : ngroups;
    const bool has_gain = jb.gain != nullptr;
    const float* gp = has_gain ? jb.gain : p.ev_norm;
    if (ntn == 0) {
      for (int t = first; t < jb.K / 64; t += gridDim.x) {
        const int k0 = t * 64, nn = tid & 63, kk0 = tid >> 6;
        float lv[2][8];
#pragma unroll
        for (int q = 0; q < 2; ++q)
#pragma unroll
          for (int i = 0; i < 8; ++i) lv[q][i] = jb.src[(size_t)(k0 + kk0 + 8 * i) * jb.N + q * 64 + nn];
#pragma unroll
        for (int q = 0; q < 2; ++q)
#pragma unroll
          for (int i = 0; i < 8; ++i) tile[q * 4160 + (kk0 + 8 * i) * 65 + nn] = lv[q][i];
        __syncthreads();
        const int n = tid >> 3, kc = tid & 7;
#pragma unroll
        for (int q = 0; q < 2; ++q) {
          float v[8];
#pragma unroll
          for (int e = 0; e < 8; ++e) v[e] = tile[q * 4160 + (kc * 8 + e) * 65 + n];
          u32x4 w; w.x = pack2(v[0], v[1]); w.y = pack2(v[2], v[3]); w.z = pack2(v[4], v[5]); w.w = pack2(v[6], v[7]);
          const int e = q * 64 + n, kk = k0 + kc * 8;
          *(u32x4*)(jb.dst + ((size_t)(((kk >> 4) * 4 + (e >> 5)) * 64 + (kc & 1) * 32 + (e & 31))) * 8) = w;
        }
        __syncthreads();
      }
      continue;
    }
    {
      const int nn = tid & 63, kk0 = tid >> 6, n = tid >> 3, kc = tid & 7;
      float lv[4][8]; int scq[4];
      int t = first;
      if (t < ngroups) {
        const int k0 = (t / ntn) * 64, n0 = (t % ntn) * 256;
#pragma unroll
        for (int q = 0; q < 4; ++q) {
          scq[q] = map_col(jb.kind, n0 + q * 64 + nn);
          const float* sp = jb.src + (size_t)(k0 + kk0) * jb.N + (scq[q] >= 0 ? scq[q] : 0);
#pragma unroll
          for (int i = 0; i < 8; ++i) lv[q][i] = __builtin_nontemporal_load(sp + (size_t)(8 * i) * jb.N);
        }
      }
      for (; t < ngroups; t += gridDim.x) {
        const int k0 = (t / ntn) * 64, n0 = (t % ntn) * 256;
        const f32x4 ga = *(const f32x4*)(gp + (has_gain ? k0 + kc * 8 : 0)), gb = *(const f32x4*)(gp + (has_gain ? k0 + kc * 8 + 4 : 0));
#pragma unroll
        for (int q = 0; q < 4; ++q)
#pragma unroll
          for (int i = 0; i < 8; ++i) tile[q * 4160 + (kk0 + 8 * i) * 65 + nn] = scq[q] >= 0 ? lv[q][i] : 0.f;
        __syncthreads();
        const int tn = t + gridDim.x;
        if (tn < ngroups) {
          const int k1 = (tn / ntn) * 64, n1 = (tn % ntn) * 256;
#pragma unroll
          for (int q = 0; q < 4; ++q) {
            scq[q] = map_col(jb.kind, n1 + q * 64 + nn);
            const float* sp = jb.src + (size_t)(k1 + kk0) * jb.N + (scq[q] >= 0 ? scq[q] : 0);
#pragma unroll
            for (int i = 0; i < 8; ++i) lv[q][i] = __builtin_nontemporal_load(sp + (size_t)(8 * i) * jb.N);
          }
        }
#pragma unroll
        for (int q = 0; q < 4; ++q) {
          float v[8];
#pragma unroll
          for (int e = 0; e < 8; ++e) v[e] = tile[q * 4160 + (kc * 8 + e) * 65 + n];
          if (has_gain) { v[0] *= ga[0]; v[1] *= ga[1]; v[2] *= ga[2]; v[3] *= ga[3]; v[4] *= gb[0]; v[5] *= gb[1]; v[6] *= gb[2]; v[7] *= gb[3]; }
          u32x4 w; w.x = pack2(v[0], v[1]); w.y = pack2(v[2], v[3]); w.z = pack2(v[4], v[5]); w.w = pack2(v[6], v[7]);
          __builtin_nontemporal_store(w, (u32x4*)(jb.dst + (size_t)(n0 + q * 64 + n) * jb.K + k0 + kc * 8));
        }
        __syncthreads();
      }
    }
  }
}

DI void cast_phase(const float* X, bf16_t* out, float* ssq) {
  const int wid = threadIdx.x >> 6, lane = threadIdx.x & 63;
  for (int row = blockIdx.x * 8 + wid; row < NTOK; row += gridDim.x * 8) {
    const f32x4* xr = (const f32x4*)(X + (size_t)row * DM);
    f32x4 v[8]; float ss = 0.f;
#pragma unroll
    for (int i = 0; i < 8; ++i) { v[i] = __builtin_nontemporal_load(xr + lane + 64 * i); ss += v[i][0] * v[i][0] + v[i][1] * v[i][1] + v[i][2] * v[i][2] + v[i][3] * v[i][3]; }
#pragma unroll
    for (int o = 1; o < 64; o <<= 1) ss += __shfl_xor(ss, o);
    if (lane < 32) ssq[(size_t)row * 32 + lane] = lane == 0 ? ss : 0.f;
#pragma unroll
    for (int i = 0; i < 8; ++i) {
      u32x2 w; w.x = pack2(v[i][0], v[i][1]); w.y = pack2(v[i][2], v[i][3]);
      *(u32x2*)(out + (size_t)row * DM + (lane + 64 * i) * 4) = w;
    }
  }
}

DI void unpack8(const u32x4 w, float (&f)[8]) { f[0] = lo_f(w.x); f[1] = hi_f(w.x); f[2] = lo_f(w.y); f[3] = hi_f(w.y); f[4] = lo_f(w.z); f[5] = hi_f(w.z); f[6] = lo_f(w.w); f[7] = hi_f(w.w); }
DI u32x4 pack8(const float (&f)[8]) { u32x4 w; w.x = pack2(f[0], f[1]); w.y = pack2(f[2], f[3]); w.z = pack2(f[4], f[5]); w.w = pack2(f[6], f[7]); return w; }

DI void ffn_fixup(const Params& p, const float* cw) {
  for (unsigned idx = blockIdx.x * 512 + threadIdx.x; idx < 256u * 2u * 1408u; idx += gridDim.x * 512) {
    const int c4 = idx % 1408, jr = (idx / 1408) & 1, sp = idx / 2816, col = c4 * 4;
    f32x4 a = *(const f32x4*)(((float*)(p.ws + OFF_headA)) + (size_t)(sp * 2 + jr) * DFF + col);
    const f32x4 uu = *(const f32x4*)(((float*)(p.ws + OFF_headU)) + (size_t)(sp * 2 + jr) * DFF + col);
    if (sp & 63) {
      const f32x4 g1 = *(const f32x4*)(((float*)(p.ws + OFF_tailG)) + (size_t)((sp - 1) * 2 + 1) * DFF + col), g2 = *(const f32x4*)(((float*)(p.ws + OFF_tailG)) + (size_t)((sp - 1) * 2) * DFF + col);
      const f32x4 w0 = *(const f32x4*)(cw + col), w1 = *(const f32x4*)(cw + DFF + col);
      if (jr == 0) a += w1 * g1 + w0 * g2; else a += w0 * g1;
    }
    u32x2 w; w.x = pack2(silu_f(a[0]) * uu[0], silu_f(a[1]) * uu[1]); w.y = pack2(silu_f(a[2]) * uu[2], silu_f(a[3]) * uu[3]);
    *(u32x2*)(((bf16_t*)(p.ws + OFF_H)) + (size_t)(sp * 64 + jr) * DFF + col) = w;
  }
}
DI void ew_odd(const Params& p) {
  const float* cw = p.od_conv_w;
  const unsigned stride = gridDim.x * 512u;
  for (unsigned idx = blockIdx.x * 512 + threadIdx.x; idx < 512u * 256u; idx += stride) {
    const int hr = idx >> 8, j0 = (idx & 255) * 8, sp = hr >> 1, lr = hr & 1, r = sp * 64 + lr;
    float bg[8], c[8], o[8];
    unpack8(*(const u32x4*)(((bf16_t*)(p.ws + OFF_A6)) + (size_t)r * DM + j0), bg);
    const float* hc = ((float*)(p.ws + OFF_headC)) + (size_t)hr * DM + j0;
    const f32x4 ca = *(const f32x4*)hc, cb = *(const f32x4*)(hc + 4);
    const int spp = (sp & 63) ? sp - 1 : sp;
    const float* t1 = ((float*)(p.ws + OFF_tailM)) + (size_t)(spp * 2 + 1) * DM + j0; const float* t0 = ((float*)(p.ws + OFF_tailM)) + (size_t)(spp * 2) * DM + j0;
    const f32x4 t1a = *(const f32x4*)t1, t1b = *(const f32x4*)(t1 + 4), t0a = *(const f32x4*)t0, t0b = *(const f32x4*)(t0 + 4);
    const f32x4 w0a = *(const f32x4*)(cw + j0), w0b = *(const f32x4*)(cw + j0 + 4), w1a = *(const f32x4*)(cw + 2048 + j0), w1b = *(const f32x4*)(cw + 2048 + j0 + 4);
    const float on = (sp & 63) ? 1.0f : 0.0f;
#pragma unroll
    for (int e = 0; e < 4; ++e) {
      const float xa = (lr == 0) ? (w1a[e] * t1a[e] + w0a[e] * t0a[e]) : (w0a[e] * t1a[e]);
      const float xb = (lr == 0) ? (w1b[e] * t1b[e] + w0b[e] * t0b[e]) : (w0b[e] * t1b[e]);
      c[e] = ca[e] + on * xa; c[4 + e] = cb[e] + on * xb;
    }
    const float* sq = ((float*)(p.ws + OFF_ssq)) + (size_t)2 * NTOK * 32 + (size_t)r * 32;
    float sm = 0.f;
#pragma unroll
    for (int e = 0; e < 8; ++e) { const f32x4 q4 = *(const f32x4*)(sq + 4 * e); sm += (q4[0] + q4[1]) + (q4[2] + q4[3]); }
    const float rs = rsqrtf(sm * (1.0f / 2048.f) + EPSF);
#pragma unroll
    for (int e = 0; e < 8; ++e) o[e] = bg[e] * rs * c[e];
    *(u32x4*)(((bf16_t*)(p.ws + OFF_A6)) + (size_t)r * DM + j0) = pack8(o);
  }
}

DI void prep_tokens(const Params& p) {
  const int wid = threadIdx.x >> 6, lane = threadIdx.x & 63;
  const bool bal = gridDim.x == 256;
  const int ntk = bal ? (blockIdx.x < 128 ? 4 : 12) : (NTOK - ((int)blockIdx.x * 8 + wid) + (int)gridDim.x * 8 - 1) / ((int)gridDim.x * 8);
  for (int ti = 0; ti < ntk; ++ti) {
    const int tok = bal ? (blockIdx.x < 128 ? (int)blockIdx.x * 32 + wid * 4 + ti : 4096 + ((int)blockIdx.x - 128) * 96 + wid * 12 + ti)
                        : (int)blockIdx.x * 8 + wid + ti * (int)gridDim.x * 8;
    const bf16_t* pr = ((bf16_t*)(p.ws + OFF_P)) + (size_t)tok * LDP;
    {
      float v[16]; float a[8], b[8];
      unpack8(*(const u32x4*)(pr + lane * 16), a); unpack8(*(const u32x4*)(pr + lane * 16 + 8), b);
      float ss = 0.f;
#pragma unroll
      for (int e = 0; e < 8; ++e) { v[e] = a[e]; v[8 + e] = b[e]; ss += a[e] * a[e] + b[e] * b[e]; }
      ss += __shfl_xor(ss, 1); ss += __shfl_xor(ss, 2); ss += __shfl_xor(ss, 4);
      const float rs = rsqrtf(ss * (1.0f / 128.f) + EPSF) * (0.08838834764831845f * 1.4426950408889634f);
      const int d0 = (lane * 16) & 127;
#pragma unroll
      for (int e = 0; e < 8; ++e) { a[e] = v[e] * rs * p.ev_q_gain[d0 + e]; b[e] = v[8 + e] * rs * p.ev_q_gain[d0 + 8 + e]; }
      *(u32x4*)(((bf16_t*)(p.ws + OFF_qn)) + (size_t)tok * 1024 + lane * 16) = pack8(a);
      *(u32x4*)(((bf16_t*)(p.ws + OFF_qn)) + (size_t)tok * 1024 + lane * 16 + 8) = pack8(b);
    }
    const int bb = tok >> 12, s = tok & 4095, g = lane >> 5, d0 = (lane * 4) & 127;
#pragma unroll
    for (int which = 0; which < 2; ++which) {
      const u32x2 w = *(const u32x2*)(pr + (which ? 2048 : 1536) + lane * 4);
      const float v0 = lo_f(w.x), v1 = hi_f(w.x), v2 = lo_f(w.y), v3 = hi_f(w.y);
      float ss = v0 * v0 + v1 * v1 + v2 * v2 + v3 * v3;
#pragma unroll
      for (int o = 1; o < 32; o <<= 1) ss += __shfl_xor(ss, o);
      const float rs = rsqrtf(ss * (1.0f / 128.f) + EPSF);
      const float* kg = p.ev_k_gain + (which ? 256 : 128) + d0;
      u32x2 o2; o2.x = pack2(v0 * rs * kg[0], v1 * rs * kg[1]); o2.y = pack2(v2 * rs * kg[2], v3 * rs * kg[3]);
      bf16_t* dst = (which ? ((bf16_t*)(p.ws + OFF_kwn)) : ((bf16_t*)(p.ws + OFF_ksn))) + ((size_t)(bb * 2 + g) * SEQ + s) * 128 + d0;
      *(u32x2*)dst = o2;
    }
  }
}
DI void prep_vtrans(const Params& p, unsigned char* smem) {
  bf16_t* tl = (bf16_t*)smem;
  const int tid = threadIdx.x;
  const bool bal = gridDim.x == 256;
  const int nit = bal ? (blockIdx.x < 128 ? 0 : 8) : (1024 - (int)blockIdx.x + (int)gridDim.x - 1) / (int)gridDim.x;
  for (int k = 0; k < nit; ++k) {
    const int it = bal ? ((int)blockIdx.x - 128) * 8 + k : (int)blockIdx.x + k * (int)gridDim.x;
    const int st = it & 63, g = (it >> 6) & 1, bb = (it >> 7) & 3, which = it >> 9;
    const int colbase = (which ? 2304 : 1792) + g * 128;
#pragma unroll
    for (int i = 0; i < 2; ++i) { const int c = tid + 512 * i, row = c >> 4, c16 = c & 15;
      *(u32x4*)(tl + row * 136 + c16 * 8) = *(const u32x4*)(((bf16_t*)(p.ws + OFF_P)) + (size_t)(bb * SEQ + st * 64 + row) * LDP + colbase + c16 * 8); }
    __syncthreads();
    const int d = tid >> 2, chk = tid & 3;
    float a[8], b[8];
#pragma unroll
    for (int e = 0; e < 8; ++e) { a[e] = bf2f(tl[(chk * 16 + e) * 136 + d]); b[e] = bf2f(tl[(chk * 16 + 8 + e) * 136 + d]); }
    bf16_t* dst = (which ? ((bf16_t*)(p.ws + OFF_vwT)) : ((bf16_t*)(p.ws + OFF_vsT))) + ((size_t)(bb * 2 + g) * 128 + d) * SEQ + st * 64 + chk * 16;
    *(u32x4*)dst = pack8(a); *(u32x4*)(dst + 8) = pack8(b);
    __syncthreads();
  }
}
DI void prep_compress(const Params& p, unsigned char* smem) {
  float* part = (float*)smem;
  float* hid = (float*)(smem + 65536);
  const int tid = threadIdx.x, wid = tid >> 6, lane = tid & 63, r = lane & 31, h = lane >> 5;
  for (int it = blockIdx.x; it < 128; it += gridDim.x) {
    const int nt = it & 7, g = (it >> 3) & 1, bb = (it >> 4) & 3, which = it >> 6;
    const bf16_t* w1t = which ? ((bf16_t*)(p.ws + OFF_w1t_v)) : ((bf16_t*)(p.ws + OFF_w1t_k));
    const float* w2 = which ? p.ev_cmp_v_w2 : p.ev_cmp_k_w2;
    const int n = nt * 32 + r; const bool nvalid = n < 255;
    const int colbase = (which ? 1280 : 1024) + g * 128;
    f32x16 acc[4];
#pragma unroll
    for (int e = 0; e < 4; ++e)
#pragma unroll
      for (int i = 0; i < 16; ++i) acc[e][i] = 0.f;
#pragma unroll 8
    for (int st = wid * 32; st < wid * 32 + 32; ++st) {
      const int l = st >> 3, d = ((st & 7) << 4) + 8 * h;
      bf16x8 af;
      {
        float a[8];
        const int tok = nvalid ? 16 * n + l : 0;
        unpack8(*(const u32x4*)(((bf16_t*)(p.ws + OFF_P)) + (size_t)(bb * SEQ + tok) * LDP + colbase + d), a);
        const float* pe = p.ev_cmp_pe + l * 128 + d;
#pragma unroll
        for (int e = 0; e < 8; ++e) a[e] = nvalid ? a[e] + pe[e] : 0.f;
        af = __builtin_bit_cast(bf16x8, pack8(a));
      }
#pragma unroll
      for (int et = 0; et < 4; ++et) {
        const bf16x8 bf = *(const bf16x8*)(w1t + ((size_t)((st * 4 + et) * 64 + h * 32 + r)) * 8);
        acc[et] = MFMA32(af, bf, acc[et]);
      }
    }
    if (wid >= 4) {
#pragma unroll
      for (int et = 0; et < 4; ++et)
#pragma unroll
        for (int i = 0; i < 16; ++i) part[((wid - 4) * 32 + ((i & 3) + 8 * (i >> 2) + 4 * h)) * 128 + 32 * et + r] = acc[et][i];
    }
    __syncthreads();
    if (wid < 4) {
#pragma unroll
      for (int et = 0; et < 4; ++et)
#pragma unroll
        for (int i = 0; i < 16; ++i) { float* q = &part[(wid * 32 + ((i & 3) + 8 * (i >> 2) + 4 * h)) * 128 + 32 * et + r]; *q = *q + acc[et][i]; }
    }
    __syncthreads();
    for (int i = tid; i < 4096; i += 512) hid[i] = gelu_tanh((part[i] + part[4096 + i]) + (part[8192 + i] + part[12288 + i]));
    __syncthreads();
    {
      const int nl = tid >> 4, f0 = (tid & 15) * 8;
      float o[8];
#pragma unroll
      for (int e = 0; e < 8; ++e) o[e] = 0.f;
#pragma unroll 16
      for (int e = 0; e < 128; ++e) {
        const float hv = hid[nl * 128 + e];
        const f32x4 wa = *(const f32x4*)(w2 + e * 128 + f0), wb = *(const f32x4*)(w2 + e * 128 + f0 + 4);
        o[0] += hv * wa[0]; o[1] += hv * wa[1]; o[2] += hv * wa[2]; o[3] += hv * wa[3];
        o[4] += hv * wb[0]; o[5] += hv * wb[1]; o[6] += hv * wb[2]; o[7] += hv * wb[3];
      }
      const int ng = nt * 32 + nl;
      if (which == 0) {
        float ss = 0.f;
#pragma unroll
        for (int e = 0; e < 8; ++e) ss += o[e] * o[e];
        ss += __shfl_xor(ss, 1); ss += __shfl_xor(ss, 2); ss += __shfl_xor(ss, 4); ss += __shfl_xor(ss, 8);
        const float rs = rsqrtf(ss * (1.0f / 128.f) + EPSF);
#pragma unroll
        for (int e = 0; e < 8; ++e) o[e] = ng < 255 ? o[e] * rs * p.ev_k_gain[f0 + e] : 0.f;
        *(u32x4*)(((bf16_t*)(p.ws + OFF_kcn)) + ((size_t)(bb * 2 + g) * 256 + ng) * 128 + f0) = pack8(o);
      } else {
#pragma unroll
        for (int e = 0; e < 8; ++e) ((bf16_t*)(p.ws + OFF_vcT))[((size_t)(bb * 2 + g) * 128 + f0 + e) * 256 + ng] = (bf16_t)(pack2(ng < 255 ? o[e] : 0.f, 0.f) & 0xffffu);
      }
    }
    __syncthreads();
  }
}
DI void prep_gmlp(const Params& p, unsigned char* smem) {
  bf16_t* VT = (bf16_t*)smem;
  const int tid = threadIdx.x, wid = tid >> 6, lane = tid & 63, r = lane & 31, h = lane >> 5;
  const bool bal = gridDim.x == 256;
  const int nmine = bal ? (blockIdx.x < 128 ? 2 : 6) : (1024 - (int)blockIdx.x + (int)gridDim.x - 1) / (int)gridDim.x;
  for (int k = 0; k < nmine; ++k) {
    const int it = bal ? (blockIdx.x < 128 ? (int)blockIdx.x + 128 * k : 256 + ((int)blockIdx.x - 128) * 6 + k) : (int)blockIdx.x + k * (int)gridDim.x;
    const int g = it & 7, c = (it >> 3) & 31, bb = it >> 8;
    const size_t T0 = (size_t)bb * SEQ + c * 128;
    const int ti = wid >> 1, dh = wid & 1, t = 32 * ti + r, nst = 2 * (ti + 1);
    const float* wrow = p.ev_gmlp_ws + ((size_t)g * 128 + t) * 128;
    f32x4 wv[8][2];
#pragma unroll
    for (int st = 0; st < 8; ++st) {
      if (st < nst) { wv[st][0] = *(const f32x4*)(wrow + 16 * st + 8 * h); wv[st][1] = *(const f32x4*)(wrow + 16 * st + 8 * h + 4); }
      else { wv[st][0] = (f32x4){0.f, 0.f, 0.f, 0.f}; wv[st][1] = (f32x4){0.f, 0.f, 0.f, 0.f}; }
    }
    {
      const int tt = tid >> 2, qd = tid & 3;
      const bf16_t* src = ((bf16_t*)(p.ws + OFF_P)) + (T0 + tt) * LDP + 3584 + g * 128 + 32 * qd;
      float z[32];
#pragma unroll
      for (int i = 0; i < 4; ++i) { float a[8]; unpack8(*(const u32x4*)(src + 8 * i), a);
#pragma unroll
        for (int e = 0; e < 8; ++e) z[8 * i + e] = gelu_tanh(a[e]); }
      float sm = 0.f;
#pragma unroll
      for (int e = 0; e < 32; ++e) sm += z[e];
      sm += __shfl_xor(sm, 1); sm += __shfl_xor(sm, 2);
      const float mean = sm * (1.0f / 128.f);
      float sv = 0.f;
#pragma unroll
      for (int e = 0; e < 32; ++e) { z[e] -= mean; sv += z[e] * z[e]; }
      sv += __shfl_xor(sv, 1); sv += __shfl_xor(sv, 2);
      const float rs = rsqrtf(sv * (1.0f / 128.f) + EPSF);
      const float* gn = p.ev_gmlp_norm + g * 128 + 32 * qd;
#pragma unroll
      for (int e = 0; e < 32; e += 2) { const unsigned w = pack2(z[e] * rs * gn[e], z[e + 1] * rs * gn[e + 1]);
        VT[(32 * qd + e) * 136 + tt] = (bf16_t)(w & 0xffffu); VT[(32 * qd + e + 1) * 136 + tt] = (bf16_t)(w >> 16); }
    }
    __syncthreads();
    {
      f32x16 acc[2];
#pragma unroll
      for (int e = 0; e < 2; ++e)
#pragma unroll
        for (int i = 0; i < 16; ++i) acc[e][i] = 0.f;
#pragma unroll
      for (int st = 0; st < 8; ++st) {
        if (st < nst) {
          const int s0 = 16 * st + 8 * h;
          float a[8] = {wv[st][0][0], wv[st][0][1], wv[st][0][2], wv[st][0][3], wv[st][1][0], wv[st][1][1], wv[st][1][2], wv[st][1][3]};
#pragma unroll
          for (int e = 0; e < 8; ++e) a[e] = (s0 + e <= t) ? a[e] : 0.f;
          const bf16x8 af = __builtin_bit_cast(bf16x8, pack8(a));
#pragma unroll
          for (int e = 0; e < 2; ++e) {
            const bf16x8 bf = *(const bf16x8*)(VT + (32 * (2 * dh + e) + r) * 136 + s0);
            acc[e] = MFMA32(af, bf, acc[e]);
          }
        }
      }
#pragma unroll
      for (int e = 0; e < 2; ++e)
#pragma unroll
        for (int i = 0; i < 16; ++i) {
          const int to = 32 * ti + (i & 3) + 8 * (i >> 2) + 4 * h, d = 32 * (2 * dh + e) + r;
          const float u = gelu_tanh(bf2f(((bf16_t*)(p.ws + OFF_P))[(T0 + to) * LDP + 2560 + g * 128 + d]));
          const float o = u * (acc[e][i] + p.ev_gmlp_b[g * 128 + to]);
          ((bf16_t*)(p.ws + OFF_omix))[(T0 + to) * DM + 1024 + g * 128 + d] = (bf16_t)(pack2(o, 0.f) & 0xffffu);
        }
    }
    __syncthreads();
  }
}

struct AttnCtx {
  const bf16_t* Kg; const bf16_t* Vg; int vstride;
};
DI void stage_load(const AttnCtx& c, int key0, u32x4 (&kr)[2], u32x4 (&vr)[2]) {
  const int tid = threadIdx.x;
#pragma unroll
  for (int i = 0; i < 2; ++i) { const int ch = tid + 512 * i;
    kr[i] = *(const u32x4*)(c.Kg + (size_t)key0 * 128 + ch * 8);
    vr[i] = *(const u32x4*)(c.Vg + (size_t)(ch >> 3) * c.vstride + key0 + (ch & 7) * 8); }
}
DI void stage_store(unsigned char* Kt, unsigned char* Vt, const u32x4 (&kr)[2], const u32x4 (&vr)[2]) {
  const int tid = threadIdx.x;
#pragma unroll
  for (int i = 0; i < 2; ++i) { const int ch = tid + 512 * i;
    *(u32x4*)(Kt + (ch >> 4) * 272 + (ch & 15) * 16) = kr[i];
    unsigned char* vp = Vt + (ch >> 3) * 136 + (ch & 7) * 16;
    *(u32x2*)vp = (u32x2){vr[i].x, vr[i].y}; *(u32x2*)(vp + 8) = (u32x2){vr[i].z, vr[i].w}; }
}

template <int MODE>
DI void attn_branch(const AttnCtx& c, unsigned long long tmask, unsigned char* Kb, unsigned char* Vb, int& cur, const bf16x8 (&qf)[8],
                    f32x16 (&o)[4], float& m, float& l, float inv_l, int pos, unsigned long long mysel, float* imp, int pl, int hr, int r, int h, int qb, unsigned long long tmask2 = 0ull) {
  u32x4 kr[2], vr[2];
  int j = __builtin_ctzll(tmask);
  stage_load(c, 64 * j, kr, vr);
  float carry = 0.f;
  for (;;) {
    cur ^= 1;
    unsigned char* Kt = Kb + cur * 17408; unsigned char* Vt = Vb + cur * 17408;
    stage_store(Kt, Vt, kr, vr);
    __syncthreads();
    tmask &= tmask - 1;
    if (tmask == 0ull) { tmask = tmask2; tmask2 = 0ull; }
    const bool more = tmask != 0ull;
    int jn = 0;
    if (more) { jn = __builtin_ctzll(tmask); stage_load(c, 64 * jn, kr, vr); }
    f32x16 s0, s1;
#pragma unroll
    for (int i = 0; i < 16; ++i) { s0[i] = 0.f; s1[i] = 0.f; }
#pragma unroll
    for (int st = 0; st < 8; ++st) {
      const bf16x8 k0 = *(const bf16x8*)(Kt + r * 272 + st * 32 + h * 16);
      const bf16x8 k1 = *(const bf16x8*)(Kt + (32 + r) * 272 + st * 32 + h * 16);
      s0 = MFMA32(k0, qf[st], s0); s1 = MFMA32(k1, qf[st], s1);
    }
    int hi, lo = -100000;
    if (MODE <= 1) hi = ((pos - 31) >> 4) - 64 * j;
    else if (MODE == 2) hi = ((mysel >> j) & 1ull) ? pos - 64 * j : -1;
    else { hi = pos - 64 * j; lo = pos - 511 - 64 * j; }
    hi -= 4 * h; lo -= 4 * h;
    float pv0[16], pv1[16];
    if (MODE == 1) {
#pragma unroll
      for (int i = 0; i < 16; ++i) {
        const int kc = (i & 3) + 8 * (i >> 2);
        pv0[i] = (kc <= hi && kc >= lo) ? __builtin_amdgcn_exp2f(s0[i] - m) * inv_l : 0.f;
        pv1[i] = (kc + 32 <= hi && kc + 32 >= lo) ? __builtin_amdgcn_exp2f(s1[i] - m) * inv_l : 0.f;
      }
#pragma unroll
      for (int u = 0; u < 2; ++u)
#pragma unroll
        for (int a = 0; a < 4; ++a) {
          const float p0 = u ? pv1[4 * a] : pv0[4 * a], p1 = u ? pv1[4 * a + 1] : pv0[4 * a + 1], p2 = u ? pv1[4 * a + 2] : pv0[4 * a + 2], p3 = u ? pv1[4 * a + 3] : pv0[4 * a + 3];
          const float p3o = __shfl_xor(p3, 32);
          float val = ((p0 + p1) + (p2 + p3)) + (h ? p3o : carry);
          carry = p3o;
          val += __shfl_xor(val, 1); val += __shfl_xor(val, 2);
          if (hr == 0) imp[pl * 65 + 16 * j + 8 * u + 2 * a + h] = val;
        }
    } else {
      const bool slow = (MODE == 0) || (j == qb) || (MODE == 3 && qb >= 8 && j == qb - 8);
      const bool lane_on = (MODE == 2) ? (((mysel >> j) & 1ull) != 0ull) : true;
      const float ninf = -__builtin_inff();
      if (slow) {
        asm volatile("" : "+v"(hi), "+v"(lo));
#pragma unroll
        for (int i = 0; i < 16; ++i) {
          const int kc = (i & 3) + 8 * (i >> 2);
          s0[i] = (kc <= hi && kc >= lo) ? s0[i] : ninf;
          s1[i] = (kc + 32 <= hi && kc + 32 >= lo) ? s1[i] : ninf;
        }
      }
      float tmax = ninf;
#pragma unroll
      for (int i = 0; i < 16; ++i) { tmax = __builtin_amdgcn_fmed3f(tmax, s0[i], __builtin_inff()); tmax = __builtin_amdgcn_fmed3f(tmax, s1[i], __builtin_inff()); }
      tmax = lane_on ? tmax : ninf;
      tmax = fmaxf(tmax, __shfl_xor(tmax, 32));
      const bool need = (MODE == 0) ? (tmax > m) : (tmax > m + 8.0f);
      if (__builtin_amdgcn_ballot_w64(need) != 0ull) {
        asm volatile("" ::);
        const float mn = need ? tmax : m;
        const float alpha = __builtin_amdgcn_exp2f(m - mn);
        m = mn; l *= alpha;
        if (MODE != 0) {
#pragma unroll
          for (int dt = 0; dt < 4; ++dt)
#pragma unroll
            for (int i = 0; i < 16; ++i) o[dt][i] *= alpha;
        }
      }
      const float meff = lane_on ? m : __builtin_inff();
      float ps = 0.f;
#pragma unroll
      for (int i = 0; i < 16; ++i) {
        pv0[i] = __builtin_amdgcn_exp2f(s0[i] - meff);
        pv1[i] = __builtin_amdgcn_exp2f(s1[i] - meff);
        ps += pv0[i] + pv1[i];
      }
      l += ps;
    }
    if (MODE != 0) {
#pragma unroll
      for (int u = 0; u < 2; ++u)
#pragma unroll
        for (int s = 0; s < 2; ++s) {
          u32x4 pw;
          if (u == 0) { pw.x = pack2(pv0[8 * s], pv0[8 * s + 1]); pw.y = pack2(pv0[8 * s + 2], pv0[8 * s + 3]); pw.z = pack2(pv0[8 * s + 4], pv0[8 * s + 5]); pw.w = pack2(pv0[8 * s + 6], pv0[8 * s + 7]); }
          else { pw.x = pack2(pv1[8 * s], pv1[8 * s + 1]); pw.y = pack2(pv1[8 * s + 2], pv1[8 * s + 3]); pw.z = pack2(pv1[8 * s + 4], pv1[8 * s + 5]); pw.w = pack2(pv1[8 * s + 6], pv1[8 * s + 7]); }
          const bf16x8 pf = __builtin_bit_cast(bf16x8, pw);
#pragma unroll
          for (int dt = 0; dt < 4; ++dt) {
            const unsigned char* vp = Vt + (32 * dt + r) * 136 + (32 * u + 16 * s + 4 * h) * 2;
            const u32x2 va = *(const u32x2*)vp, vb = *(const u32x2*)(vp + 16);
            const bf16x8 vf = __builtin_bit_cast(bf16x8, (u32x4){va.x, va.y, vb.x, vb.y});
            o[dt] = MFMA32(vf, pf, o[dt]);
          }
        }
    }
    if (!more) break;
    j = jn;
  }
}

DI void attn_phase(const Params& p, unsigned char* smem) {
  unsigned char* Kb = smem;
  unsigned char* Vb = smem + 34816;
  float* imp = (float*)(smem + 69632);
  unsigned* selw = (unsigned*)(smem + 69632 + 16640);
  unsigned* uni = selw + 128;
  const int tid = threadIdx.x, wid = tid >> 6, lane = tid & 63, r = lane & 31, h = lane >> 5;
  int cur = 0;
  for (int it = blockIdx.x; it < 512; it += gridDim.x) {
    const int pi = it & 255, bg = pi & 7, qi = pi >> 3;
    const int qb = (it < 256) ? 63 - qi : qi;
    const int bb = bg >> 1, g = bg & 1;
    const int q0 = qb * 64, pl = wid * 8 + (r >> 2), pos = q0 + pl, hr = r & 3, head = g * 4 + hr;
    const size_t token = (size_t)bb * SEQ + pos;
    bf16x8 qf[8];
    {
      const bf16_t* qp = ((bf16_t*)(p.ws + OFF_qn)) + token * 1024 + head * 128 + 8 * h;
#pragma unroll
      for (int st = 0; st < 8; ++st) qf[st] = *(const bf16x8*)(qp + 16 * st);
    }
    for (int i = tid; i < 64 * 65; i += 512) imp[i] = 0.f;
    f32x16 o[4];
    const size_t kvh = (size_t)(bb * 2 + g);
    {
      AttnCtx c; c.Kg = ((bf16_t*)(p.ws + OFF_kcn)) + kvh * 256 * 128; c.Vg = ((bf16_t*)(p.ws + OFF_vcT)) + kvh * 128 * 256; c.vstride = 256;
      const int nmax = (q0 + 32) >> 4;
      const int ntl = min(4, (nmax >> 6) + 1);
      const unsigned long long tm = (1ull << ntl) - 1ull;
      float m = NEGF, l = 0.f;
      attn_branch<0>(c, tm, Kb, Vb, cur, qf, o, m, l, 0.f, pos, 0ull, imp, pl, hr, r, h, qb);
      const float lt = l + __shfl_xor(l, 32);
      const float inv_l = lt > 0.f ? 1.0f / lt : 0.f;
#pragma unroll
      for (int dt = 0; dt < 4; ++dt)
#pragma unroll
        for (int i = 0; i < 16; ++i) o[dt][i] = 0.f;
      attn_branch<1>(c, tm, Kb, Vb, cur, qf, o, m, l, inv_l, pos, 0ull, imp, pl, hr, r, h, qb);
      int tk_ = (int)token; asm volatile("" : "+v"(tk_));
      const bf16_t* glp = ((bf16_t*)(p.ws + OFF_P)) + (size_t)tk_ * LDP + 4608 + head * 3;
      float* orow = ((float*)(p.ws + OFF_oacc)) + (size_t)tk_ * 1024 + head * 128;
      const float gate0 = sigmoid_f(bf2f(glp[0]));
#pragma unroll
      for (int dt = 0; dt < 4; ++dt)
#pragma unroll
        for (int a = 0; a < 4; ++a) {
          f32x4 v = {o[dt][4 * a] * gate0, o[dt][4 * a + 1] * gate0, o[dt][4 * a + 2] * gate0, o[dt][4 * a + 3] * gate0};
          *(f32x4*)(orow + 32 * dt + 8 * a + 4 * h) = v;
        }
    }
    __syncthreads();
    unsigned long long mysel, usel;
    {
      const int ps = tid >> 3, sub = tid & 7;
      unsigned* ikey = (unsigned*)imp;
      unsigned bits = 0;
      if (qb < 16) {
#pragma unroll
        for (int jj = 0; jj < 8; ++jj) bits |= ((sub * 8 + jj) <= qb) ? (1u << jj) : 0u;
        __syncthreads();
      } else {
        unsigned v[8];
#pragma unroll
        for (int jj = 0; jj < 8; ++jj) {
          const int j = sub * 8 + jj;
          const float x = imp[ps * 65 + j];
          const bool forced = (j == 0) || (j == qb) || (j == qb - 1);
          v[jj] = forced ? 0xffffffffu : (j <= qb ? __float_as_uint(fmaxf(x, 0.f)) : 0u);
        }
#pragma unroll
        for (int jj = 0; jj < 8; ++jj) ikey[ps * 65 + sub * 8 + jj] = v[jj];
        __syncthreads();
        int cnt[8];
#pragma unroll
        for (int jj = 0; jj < 8; ++jj) cnt[jj] = 0;
        for (int j2 = 0; j2 < sub * 8; ++j2) {
          const unsigned y = ikey[ps * 65 + j2];
#pragma unroll
          for (int jj = 0; jj < 8; ++jj) cnt[jj] += (y >= v[jj]) ? 1 : 0;
        }
#pragma unroll
        for (int j2 = 0; j2 < 8; ++j2) {
          const unsigned y = ikey[ps * 65 + sub * 8 + j2];
#pragma unroll
          for (int jj = 0; jj < 8; ++jj) cnt[jj] += (y > v[jj] || (y == v[jj] && j2 < jj)) ? 1 : 0;
        }
        for (int j2 = sub * 8 + 8; j2 < 64; ++j2) {
          const unsigned y = ikey[ps * 65 + j2];
#pragma unroll
          for (int jj = 0; jj < 8; ++jj) cnt[jj] += (y > v[jj]) ? 1 : 0;
        }
#pragma unroll
        for (int jj = 0; jj < 8; ++jj) bits |= (cnt[jj] < 16 && (sub * 8 + jj) <= qb) ? (1u << jj) : 0u;
      }
      unsigned w = bits << (8 * (sub & 3));
      w |= __shfl_xor(w, 1); w |= __shfl_xor(w, 2);
      if ((sub & 3) == 0) selw[ps * 2 + (sub >> 2)] = w;
      __syncthreads();
      if (tid < 64) {
        unsigned a = selw[tid * 2], b = selw[tid * 2 + 1];
#pragma unroll
        for (int of = 1; of < 64; of <<= 1) { a |= __shfl_xor(a, of); b |= __shfl_xor(b, of); }
        if (tid == 0) { uni[0] = a; uni[1] = b; }
      }
      __syncthreads();
      usel = (unsigned long long)uni[0] | ((unsigned long long)uni[1] << 32);
      mysel = (unsigned long long)selw[pl * 2] | ((unsigned long long)selw[pl * 2 + 1] << 32);
    }
    {
      AttnCtx c; c.Kg = ((bf16_t*)(p.ws + OFF_ksn)) + kvh * SEQ * 128; c.Vg = ((bf16_t*)(p.ws + OFF_vsT)) + kvh * 128 * SEQ; c.vstride = SEQ;
      float m = NEGF, l = 0.f;
#pragma unroll
      for (int dt = 0; dt < 4; ++dt)
#pragma unroll
        for (int i = 0; i < 16; ++i) o[dt][i] = 0.f;
      const int rot = (qi * 5) % (qb + 1);
      const unsigned long long lo_m = usel & ((1ull << rot) - 1ull), hi_m = usel & ~((1ull << rot) - 1ull);
      attn_branch<2>(c, hi_m ? hi_m : lo_m, Kb, Vb, cur, qf, o, m, l, 0.f, pos, mysel, imp, pl, hr, r, h, qb, hi_m ? lo_m : 0ull);
      const float lt = l + __shfl_xor(l, 32);
      int tk_ = (int)token; asm volatile("" : "+v"(tk_));
      const bf16_t* glp = ((bf16_t*)(p.ws + OFF_P)) + (size_t)tk_ * LDP + 4608 + head * 3;
      float* orow = ((float*)(p.ws + OFF_oacc)) + (size_t)tk_ * 1024 + head * 128;
      const float sc = sigmoid_f(bf2f(glp[1])) / lt;
#pragma unroll
      for (int dt = 0; dt < 4; ++dt)
#pragma unroll
        for (int a = 0; a < 4; ++a) {
          float* q = orow + 32 * dt + 8 * a + 4 * h;
          f32x4 v = *(const f32x4*)q;
          v[0] += o[dt][4 * a] * sc; v[1] += o[dt][4 * a + 1] * sc; v[2] += o[dt][4 * a + 2] * sc; v[3] += o[dt][4 * a + 3] * sc;
          *(f32x4*)q = v;
        }
    }
    {
      AttnCtx c; c.Kg = ((bf16_t*)(p.ws + OFF_kwn)) + kvh * SEQ * 128; c.Vg = ((bf16_t*)(p.ws + OFF_vwT)) + kvh * 128 * SEQ; c.vstride = SEQ;
      const int tlo = qb >= 8 ? qb - 8 : 0;
      const unsigned long long tm = (qb == 63 ? ~0ull : ((1ull << (qb + 1)) - 1ull)) & ~((1ull << tlo) - 1ull);
      float m = NEGF, l = 0.f;
#pragma unroll
      for (int dt = 0; dt < 4; ++dt)
#pragma unroll
        for (int i = 0; i < 16; ++i) o[dt][i] = 0.f;
      attn_branch<3>(c, tm, Kb, Vb, cur, qf, o, m, l, 0.f, pos, 0ull, imp, pl, hr, r, h, qb);
      const float lt = l + __shfl_xor(l, 32);
      int tk_ = (int)token; asm volatile("" : "+v"(tk_));
      const bf16_t* glp = ((bf16_t*)(p.ws + OFF_P)) + (size_t)tk_ * LDP + 4608 + head * 3;
      float* orow = ((float*)(p.ws + OFF_oacc)) + (size_t)tk_ * 1024 + head * 128;
      const float sc = sigmoid_f(bf2f(glp[2])) / lt;
      bf16_t* om = ((bf16_t*)(p.ws + OFF_omix)) + token * DM + head * 128;
#pragma unroll
      for (int dt = 0; dt < 4; ++dt)
#pragma unroll
        for (int a = 0; a < 4; ++a) {
          const float* q = orow + 32 * dt + 8 * a + 4 * h;
          f32x4 v = *(const f32x4*)q;
          v[0] += o[dt][4 * a] * sc; v[1] += o[dt][4 * a + 1] * sc; v[2] += o[dt][4 * a + 2] * sc; v[3] += o[dt][4 * a + 3] * sc;
          u32x2 w; w.x = pack2(v[0], v[1]); w.y = pack2(v[2], v[3]);
          *(u32x2*)(om + 32 * dt + 8 * a + 4 * h) = w;
        }
    }
    __syncthreads();
  }
}


#define XB_TMO      128
#define XB_XCNT(j)  (256  + 64 * (j))
#define XB_XSUB(j)  (1280 + 64 * (j))
#define XB_XGEN(j)  (2304 + 64 * (j))
#define XB_TOP      3328
#define XB_TOPGEN   3392
#define XCD_BAR_WORDS 3456
#define XB_SPIN_CAP (1u << 20)
__device__ unsigned g_bar_words[3456];
DI unsigned xb_ld(unsigned* p) { return __hip_atomic_load(p, __ATOMIC_RELAXED, __HIP_MEMORY_SCOPE_AGENT); }
DI unsigned xb_add(unsigned* p, unsigned v) { return __hip_atomic_fetch_add(p, v, __ATOMIC_RELAXED, __HIP_MEMORY_SCOPE_AGENT); }
DI unsigned xb_xcc_id() { return (unsigned)__builtin_amdgcn_s_getreg((3 << 11) | 20) & 0xFu; }
#define XB_SPIN(cond, bar) do { unsigned _sp = 0; while (cond) { __builtin_amdgcn_s_sleep(1); \
    if ((++_sp & 255u) == 0u) { if (xb_ld(&(bar)[XB_TMO])) break; if (_sp > XB_SPIN_CAP) { atomicAdd(&(bar)[XB_TMO], 1u); break; } } } } while (0)
struct XcdBarrier { unsigned* bar; unsigned x; volatile LAS unsigned* st; };
DI XcdBarrier xcd_barrier_post(unsigned* bar, volatile LAS unsigned* st) {
  XcdBarrier b; b.bar = bar; b.x = xb_xcc_id(); b.st = st;
  if (threadIdx.x == 0) {
    const unsigned raw = xb_add(&bar[XB_XCNT(b.x)], 1u);
    const bool mono = gridDim.x == 256u;
    const unsigned slot = mono ? (raw & 31u) : raw;
    st[3] = mono ? (raw >> 5) : 0u;
    st[2] = (mono && b.x < 8u) ? slot * 8u + b.x : blockIdx.x;
  }
  return b;
}
DI void xcd_barrier_complete(unsigned* bar, unsigned x, unsigned k, unsigned& nloc, unsigned& nx) {
  const unsigned G = gridDim.x * gridDim.y * gridDim.z;
  unsigned sum, cnt, mine, sp = 0u;
  for (;;) {
    sum = 0u; cnt = 0u; mine = 0u;
#pragma unroll
    for (unsigned j = 0; j < 16; ++j) { const unsigned c = xb_ld(&bar[XB_XCNT(j)]); sum += c; cnt += (c > 0u) ? 1u : 0u; mine = (j == x) ? c : mine; }
    if (sum == G * (k + 1u)) break;
    __builtin_amdgcn_s_sleep(1);
    if ((++sp & 255u) == 0u) { if (xb_ld(&bar[XB_TMO])) break; if (sp > XB_SPIN_CAP) { atomicAdd(&bar[XB_TMO], 1u); break; } }
  }
  mine -= 32u * k;
  nloc = mine > 0u ? mine : 1u; nx = cnt > 0u ? cnt : 1u;
}
DI void xcd_barrier(const XcdBarrier& b) {
  asm volatile("s_waitcnt vmcnt(0)" ::: "memory");
  __syncthreads();
  if (threadIdx.x == 0) {
    unsigned* bar = b.bar;
    __builtin_amdgcn_s_waitcnt(0);
    unsigned nloc = b.st[0], nx = b.st[1];
    if (nloc == 0u) { xcd_barrier_complete(bar, b.x, b.st[3], nloc, nx); b.st[0] = nloc; b.st[1] = nx; }
    const unsigned old = xb_add(&bar[XB_XSUB(b.x)], 1u);
    const unsigned gen = old / nloc;
    if (old + 1u == (gen + 1u) * nloc) {
      __builtin_amdgcn_fence(__ATOMIC_RELEASE, "agent");
      asm volatile("s_waitcnt vmcnt(0)" ::: "memory");
      const unsigned og = xb_add(&bar[XB_TOP], 1u);
      const unsigned tg = og / nx;
      if (og + 1u == (tg + 1u) * nx) xb_add(&bar[XB_TOPGEN], 1u);
      else XB_SPIN(xb_ld(&bar[XB_TOPGEN]) == tg, bar);
      __builtin_amdgcn_fence(__ATOMIC_ACQUIRE, "agent");
      xb_add(&bar[XB_XGEN(b.x)], 1u);
      asm volatile("s_waitcnt vmcnt(0)" ::: "memory");
    } else {
      XB_SPIN(xb_ld(&bar[XB_XGEN(b.x)]) == gen, bar);
      __builtin_amdgcn_fence(__ATOMIC_ACQUIRE, "agent");
      asm volatile("s_waitcnt vmcnt(0)" ::: "memory");
    }
  }
  __syncthreads();
}

DI void mk_barrier(unsigned* bar, unsigned char* smem) {
  XcdBarrier b; b.bar = bar; b.x = xb_xcc_id(); b.st = (volatile LAS unsigned*)(LAS unsigned char*)(smem + 131072);
  xcd_barrier(b);
}

DI void run_gemm(const Params& p, int id, unsigned char* smem) {
  pg8::Gemm g; pg8::StaticOrder S;
  bf16_t* ob = nullptr; int ldc = 0; const float* base = nullptr; int kind = 0;
  const float* cw = nullptr; const float* cb = nullptr; const float* ssq_in = nullptr; float* ssq_out = nullptr; bf16_t* xbo = ((bf16_t*)(p.ws + OFF_xb));
  switch (id) {
    case 0: g = {((bf16_t*)(p.ws + OFF_xb)), ((bf16_t*)(p.ws + OFF_wt_ev_in)), NTOK, LDP, DM}; ob = ((bf16_t*)(p.ws + OFF_P)); ldc = LDP; ssq_in = ((float*)(p.ws + OFF_ssq)); break;
    case 1: g = {((bf16_t*)(p.ws + OFF_omix)), ((bf16_t*)(p.ws + OFF_wt_ev_out)), NTOK, DM, DM}; kind = 1; base = p.x; ssq_out = ((float*)(p.ws + OFF_ssq)) + (size_t)NTOK * 32; break;
    case 2: g = {((bf16_t*)(p.ws + OFF_xb)), ((bf16_t*)(p.ws + OFF_wt_ffn_in)), NTOK, NFF2, DM}; kind = 2; cw = p.ffn_conv_w; cb = p.ffn_conv_b; ssq_in = ((float*)(p.ws + OFF_ssq)) + (size_t)NTOK * 32; break;
    case 4: g = {((bf16_t*)(p.ws + OFF_H)), ((bf16_t*)(p.ws + OFF_wt_ffn_dn)), NTOK, DM, DFF}; kind = 1; base = p.out; ssq_out = ((float*)(p.ws + OFF_ssq)) + (size_t)2 * NTOK * 32; break;
    case 5: g = {((bf16_t*)(p.ws + OFF_xb)), ((bf16_t*)(p.ws + OFF_wt_od_in)), NTOK, 6144, DM}; kind = 3; ssq_in = ((float*)(p.ws + OFF_ssq)) + (size_t)2 * NTOK * 32; break;
    case 6: g = {((bf16_t*)(p.ws + OFF_A6)), ((bf16_t*)(p.ws + OFF_wt_od_out)), NTOK, DM, DM}; kind = 1; base = p.out; ssq_out = ((float*)(p.ws + OFF_ssq)) + (size_t)3 * NTOK * 32; break;
    case 7: g = {((bf16_t*)(p.ws + OFF_xb)), ((bf16_t*)(p.ws + OFF_wt_ffn_in)) + (size_t)NFF2 * DM, NTOK, NFF2, DM}; kind = 2; cw = p.ffn_conv_w + 3 * DFF; cb = p.ffn_conv_b + DFF; ssq_in = ((float*)(p.ws + OFF_ssq)) + (size_t)3 * NTOK * 32; break;
    default: g = {((bf16_t*)(p.ws + OFF_H)), ((bf16_t*)(p.ws + OFF_wt_ffn_dn)) + (size_t)DM * DFF, NTOK, DM, DFF}; kind = 1; base = p.out; xbo = nullptr; break;
  }
  S.init(g.M, g.N, (int)gridDim.x, __builtin_amdgcn_readfirstlane((int)((volatile LAS unsigned*)(LAS unsigned char*)(smem + 131072))[2]));
  if (kind == 1) { pg8::EpiResid E; E.C = p.out; E.base = base; E.xb = xbo; E.ssq = ssq_out; pg8::gemm_phase<pg8::EpiResid>((LAS unsigned char*)smem, g, S, E); }
  else if (kind == 2) { pg8::EpiFfn E; E.H = ((bf16_t*)(p.ws + OFF_H)); E.cw = cw; E.cb = cb; E.tailG = ((float*)(p.ws + OFF_tailG)); E.headA = ((float*)(p.ws + OFF_headA)); E.headU = ((float*)(p.ws + OFF_headU)); E.ssq = ssq_in; pg8::gemm_phase<pg8::EpiFfn>((LAS unsigned char*)smem, g, S, E); }
  else if (kind == 3) { pg8::EpiOdd E; E.BG = ((bf16_t*)(p.ws + OFF_A6)); E.C = ((bf16_t*)(p.ws + OFF_Cc)); E.cw = p.od_conv_w; E.tailM = ((float*)(p.ws + OFF_tailM)); E.headC = ((float*)(p.ws + OFF_headC)); E.ssq = ssq_in; pg8::TripletOrder T; T.init((int)gridDim.x, S.c); pg8::gemm_phase<pg8::EpiOdd, pg8::TripletOrder>((LAS unsigned char*)smem, g, T, E); }
  else { pg8::EpiBf16 E; E.O = ob; E.ldc = ldc; E.ssq = ssq_in; pg8::gemm_phase<pg8::EpiBf16>((LAS unsigned char*)smem, g, S, E); }
}

#ifndef PROBE_DUP
#define PROBE_DUP -1
#endif
#define PHASE(k, body) if (p.phase_lo <= (k) && (k) < p.phase_hi) { if ((k) > p.phase_lo) { mk_barrier(gridDim.x == 256u ? g_bar_words : ((unsigned*)(p.ws + OFF_bar)), smem); } body; if ((k) == PROBE_DUP) { mk_barrier(gridDim.x == 256u ? g_bar_words : ((unsigned*)(p.ws + OFF_bar)), smem); body; } }
__global__ __launch_bounds__(512) void mega(Params p) {
  extern __shared__ __attribute__((aligned(16))) unsigned char smem[];
  cg::grid_group grid = cg::this_grid();
  volatile LAS unsigned* xst = (volatile LAS unsigned*)(LAS unsigned char*)(smem + 131072);
  if (threadIdx.x == 0) { xst[0] = 0u; xst[1] = 0u; }
  __syncthreads();
  (void)xcd_barrier_post(gridDim.x == 256u ? g_bar_words : ((unsigned*)(p.ws + OFF_bar)), xst);
  __syncthreads();
  if (p.phase_hi > 1000) grid.sync();
  PHASE(0, conv_phase(p, smem); cast_phase(p.x, ((bf16_t*)(p.ws + OFF_xb)), ((float*)(p.ws + OFF_ssq))))
  PHASE(1, run_gemm(p, 0, smem))
  PHASE(2, prep_compress(p, smem); prep_tokens(p); prep_vtrans(p, smem); prep_gmlp(p, smem))
  PHASE(3, attn_phase(p, smem))
  PHASE(4, run_gemm(p, 1, smem))
  PHASE(5, run_gemm(p, 2, smem))
  PHASE(6, ffn_fixup(p, p.ffn_conv_w))
  PHASE(7, run_gemm(p, 4, smem))
  PHASE(8, run_gemm(p, 5, smem))
  PHASE(9, ew_odd(p))
  PHASE(10, run_gemm(p, 6, smem))
  PHASE(11, run_gemm(p, 7, smem))
  PHASE(12, ffn_fixup(p, p.ffn_conv_w + 3 * DFF))
  PHASE(13, run_gemm(p, 9, smem))
}

extern "C" void kernel_launch(void* const* d_in, const int* in_sizes, int n_in, void* d_out, int out_size, void* d_ws, size_t ws_size, hipStream_t stream) {
  Params p{};
  const float* const* in = (const float* const*)d_in;
  p.x = in[0]; p.ev_norm = in[1]; p.ev_w_in = in[2]; p.ev_q_gain = in[3]; p.ev_k_gain = in[4]; p.ev_cmp_pe = in[5]; p.ev_cmp_k_w1 = in[6]; p.ev_cmp_k_w2 = in[7];
  p.ev_cmp_v_w1 = in[8]; p.ev_cmp_v_w2 = in[9]; p.ev_gmlp_norm = in[10]; p.ev_gmlp_ws = in[11]; p.ev_gmlp_b = in[12]; p.ev_w_out = in[13]; p.od_norm = in[14];
  p.od_w_in = in[15]; p.od_conv_w = in[16]; p.od_w_out = in[17]; p.ffn_norm = in[18]; p.ffn_w_in = in[19]; p.ffn_conv_w = in[20]; p.ffn_conv_b = in[21]; p.ffn_w_down = in[22];
  p.out = (float*)d_out;
  p.ws = (unsigned char*)d_ws;
  if (WS_NEED > ws_size) { fprintf(stderr, "workspace too small: need %zu have %zu\n", (size_t)WS_NEED, ws_size); return; }

  static int grid_blocks = 0;
  if (!grid_blocks) {
    hipFuncSetAttribute((const void*)mega, hipFuncAttributeMaxDynamicSharedMemorySize, LDS_BYTES);
    int dev = 0, cus = 0, per_cu = 0;
    hipGetDevice(&dev);
    hipDeviceGetAttribute(&cus, hipDeviceAttributeMultiprocessorCount, dev);
    hipOccupancyMaxActiveBlocksPerMultiprocessor(&per_cu, mega, 512, LDS_BYTES);
    if (per_cu < 1) per_cu = 1;
    grid_blocks = cus * per_cu;
  }
  if (grid_blocks != 256) (void)hipMemsetAsync(p.ws + OFF_bar, 0, (size_t)XCD_BAR_WORDS * 4, stream);
#if MULTI_LAUNCH
  for (int ph = 0; ph < NPHASE; ++ph) {
    p.phase_lo = ph; p.phase_hi = ph + 1;
    hipLaunchKernelGGL(mega, dim3(grid_blocks), dim3(512), LDS_BYTES, stream, p);
  }
#else
  p.phase_lo = 0; p.phase_hi = NPHASE;
  void* args[] = {&p};
  hipError_t e = hipLaunchCooperativeKernel((void*)mega, dim3(grid_blocks), dim3(512), args, LDS_BYTES, stream);
  if (e != hipSuccess) fprintf(stderr, "cooperative launch failed: %s (grid %d)\n", hipGetErrorString(e), grid_blocks);
#endif
}
```

```cpp
#include <hip/hip_runtime.h>
#include <hip/hip_cooperative_groups.h>
#include <cstdio>
namespace cg = cooperative_groups;

#ifndef MULTI_LAUNCH
#define MULTI_LAUNCH 0
#endif

#define DI __device__ __forceinline__
#define LAS __attribute__((address_space(3)))
typedef unsigned short bf16_t;
typedef short bf16x8 __attribute__((ext_vector_type(8)));
typedef float f32x2 __attribute__((ext_vector_type(2)));
typedef float f32x4 __attribute__((ext_vector_type(4)));
typedef float f32x16 __attribute__((ext_vector_type(16)));
typedef unsigned u32x2 __attribute__((ext_vector_type(2)));
typedef unsigned u32x4 __attribute__((ext_vector_type(4)));
typedef __bf16 bf16v2 __attribute__((ext_vector_type(2)));

constexpr int NTOK = 16384, DM = 2048, SEQ = 4096, LDP = 4864, DFF = 5632, NFF2 = 11264;
constexpr int LDS_BYTES = 131072 + 256;
constexpr int NPHASE = 14;
constexpr float EPSF = 1e-6f;
constexpr float NEGF = -1e30f;

constexpr size_t XCD_BAR_WORDS_C = 3456;
constexpr size_t OFF_bar = 0;
constexpr size_t END_bar = OFF_bar + (XCD_BAR_WORDS_C * 4);
constexpr size_t OFF_wt_ev_in = END_bar;
constexpr size_t END_wt_ev_in = OFF_wt_ev_in + ((size_t)LDP * DM * 2);
constexpr size_t OFF_wt_ev_out = END_wt_ev_in;
constexpr size_t END_wt_ev_out = OFF_wt_ev_out + ((size_t)DM * DM * 2);
constexpr size_t OFF_wt_ffn_in = END_wt_ev_out;
constexpr size_t END_wt_ffn_in = OFF_wt_ffn_in + ((size_t)2 * NFF2 * DM * 2);
constexpr size_t OFF_wt_ffn_dn = END_wt_ffn_in;
constexpr size_t END_wt_ffn_dn = OFF_wt_ffn_dn + ((size_t)2 * DM * DFF * 2);
constexpr size_t OFF_wt_od_in = END_wt_ffn_dn;
constexpr size_t END_wt_od_in = OFF_wt_od_in + ((size_t)6144 * DM * 2);
constexpr size_t OFF_wt_od_out = END_wt_od_in;
constexpr size_t END_wt_od_out = OFF_wt_od_out + ((size_t)DM * DM * 2);
constexpr size_t OFF_w1t_k = END_wt_od_out;
constexpr size_t END_w1t_k = OFF_w1t_k + ((size_t)128 * 4096 * 2);
constexpr size_t OFF_w1t_v = END_w1t_k;
constexpr size_t END_w1t_v = OFF_w1t_v + ((size_t)128 * 4096 * 2);
constexpr size_t OFF_xb = END_w1t_v;
constexpr size_t END_xb = OFF_xb + ((size_t)NTOK * DM * 2);
constexpr size_t OFF_ssq = END_xb;
constexpr size_t END_ssq = OFF_ssq + ((size_t)4 * NTOK * 32 * 4);
constexpr size_t OFF_REGION = END_ssq;
constexpr size_t OFF_P = OFF_REGION;
constexpr size_t END_P = OFF_P + ((size_t)NTOK * LDP * 2);
constexpr size_t OFF_qn = END_P;
constexpr size_t END_qn = OFF_qn + ((size_t)NTOK * 1024 * 2);
constexpr size_t OFF_ksn = END_qn;
constexpr size_t END_ksn = OFF_ksn + ((size_t)NTOK * 256 * 2);
constexpr size_t OFF_kwn = END_ksn;
constexpr size_t END_kwn = OFF_kwn + ((size_t)NTOK * 256 * 2);
constexpr size_t OFF_vsT = END_kwn;
constexpr size_t END_vsT = OFF_vsT + ((size_t)NTOK * 256 * 2);
constexpr size_t OFF_vwT = END_vsT;
constexpr size_t END_vwT = OFF_vwT + ((size_t)NTOK * 256 * 2);
constexpr size_t OFF_kcn = END_vwT;
constexpr size_t END_kcn = OFF_kcn + ((size_t)8 * 256 * 128 * 2);
constexpr size_t OFF_vcT = END_kcn;
constexpr size_t END_vcT = OFF_vcT + ((size_t)8 * 128 * 256 * 2);
constexpr size_t OFF_oacc = END_vcT;
constexpr size_t END_oacc = OFF_oacc + ((size_t)NTOK * 1024 * 4);
constexpr size_t OFF_omix = END_oacc;
constexpr size_t END_omix = OFF_omix + ((size_t)NTOK * DM * 2);
constexpr size_t OFF_H = OFF_REGION;
constexpr size_t END_H = OFF_H + ((size_t)NTOK * DFF * 2);
constexpr size_t OFF_tailG = END_H;
constexpr size_t END_tailG = OFF_tailG + ((size_t)512 * DFF * 4);
constexpr size_t OFF_headA = END_tailG;
constexpr size_t END_headA = OFF_headA + ((size_t)512 * DFF * 4);
constexpr size_t OFF_headU = END_headA;
constexpr size_t END_headU = OFF_headU + ((size_t)512 * DFF * 4);
constexpr size_t OFF_BG = OFF_REGION;
constexpr size_t END_BG = OFF_BG + ((size_t)NTOK * DM * 2);
constexpr size_t OFF_Cc = END_BG;
constexpr size_t END_Cc = OFF_Cc + ((size_t)NTOK * DM * 2);
constexpr size_t OFF_A6 = END_Cc;
constexpr size_t END_A6 = OFF_A6 + ((size_t)NTOK * DM * 2);
constexpr size_t OFF_tailM = END_A6;
constexpr size_t END_tailM = OFF_tailM + ((size_t)512 * DM * 4);
constexpr size_t OFF_headC = END_tailM;
constexpr size_t END_headC = OFF_headC + ((size_t)512 * DM * 4);
constexpr size_t WS_NEED = (END_omix > END_headU ? (END_omix > END_headC ? END_omix : END_headC) : (END_headU > END_headC ? END_headU : END_headC));
struct Params {
  const float *x, *ev_norm, *ev_w_in, *ev_q_gain, *ev_k_gain, *ev_cmp_pe, *ev_cmp_k_w1, *ev_cmp_k_w2, *ev_cmp_v_w1, *ev_cmp_v_w2,
      *ev_gmlp_norm, *ev_gmlp_ws, *ev_gmlp_b, *ev_w_out, *od_norm, *od_w_in, *od_conv_w, *od_w_out, *ffn_norm, *ffn_w_in, *ffn_conv_w,
      *ffn_conv_b, *ffn_w_down;
  float* out;
  unsigned char* ws;
  int phase_lo, phase_hi;
};

DI float bf2f(unsigned b) { return __uint_as_float(b << 16); }
DI unsigned pack2(float lo, float hi) { f32x2 v = {lo, hi}; bf16v2 r = __builtin_convertvector(v, bf16v2); return __builtin_bit_cast(unsigned, r); }
DI float lo_f(unsigned w) { return __uint_as_float(w << 16); }
DI float hi_f(unsigned w) { return __uint_as_float(w & 0xffff0000u); }
DI float sigmoid_f(float x) { return __builtin_amdgcn_rcpf(1.0f + __builtin_amdgcn_exp2f(x * -1.4426950408889634f)); }
DI float gelu_tanh(float x) { const float u = 1.5957691216057308f * (x + 0.044715f * x * x * x); return x * sigmoid_f(u); }
DI float silu_f(float x) { return x * sigmoid_f(x); }
#define MFMA32(a, b, c) __builtin_amdgcn_mfma_f32_32x32x16_bf16((a), (b), (c), 0, 0, 0)

namespace pg8 {
constexpr int BM = 256, BK = 64, HALF = 128, HTB = HALF * BK * 2, NXCD = 8, WGM = 8;
DI int lds_byte(int r, int c) { const int st = (r >> 4) * 2 + (c >> 5), rr = r & 15, cc = c & 31, ob = rr * 64 + cc * 2; return st * 1024 + (ob ^ (((ob >> 9) & 1) << 5)); }
DI void stage_rc(int b, int& R, int& C) { const int st = b / 1024, sb = b % 1024, swz = sb ^ (((sb >> 9) & 1) << 5); R = (st >> 1) * 16 + swz / 64; C = (st & 1) * 32 + (swz % 64) / 2; }
DI int perm32(int rho) { const int n = rho >> 4, i = rho & 15; return 8 * (i >> 2) + 4 * n + (i & 3); }
struct Unit { int pm, pn; };
struct Gemm { const bf16_t* A; const bf16_t* Bt; int M, N, K; };
struct StaticOrder {
  int nM, nN, nwg, G, c;
  DI void init(int M, int N, int G_, int c_) { nM = M / BM; nN = N / BM; nwg = nM * nN; G = G_; c = c_; }
  DI bool next(int i, Unit& u) const {
    const long L = (long)i * G + c; if (L >= nwg) return false;
    int wgid = (int)L; { const int q = nwg / NXCD, r = nwg % NXCD, xcd = wgid % NXCD, off = wgid / NXCD; wgid = (xcd < r ? xcd * (q + 1) : r * (q + 1) + (xcd - r) * q) + off; }
    const int nig = WGM * nN, gid = wgid / nig, fm = gid * WGM, gsz = (nM - fm) < WGM ? (nM - fm) : WGM;
    u.pm = fm + ((wgid % nig) % gsz); u.pn = (wgid % nig) / gsz; return true;
  }
};
struct TripletOrder {
  int G, c;
  DI void init(int G_, int c_) { G = G_; c = c_; }
  DI bool next(int i, Unit& u) const {
    const int rd = i / 3, k = i - 3 * rd;
    const int tr = c + G * rd; if (tr >= 512) return false;
    int pm, t;
    if (G == 256) { const int x = c & 7, q = (c >> 3) + 32 * rd; pm = 8 * x + (q & 7); t = q >> 3; }
    else { pm = tr >> 3; t = tr & 7; }
    u.pm = pm; u.pn = k < 2 ? 2 * t + k : 16 + t; return true;
  }
};
DI float row_rstd(const float* ssq, int row, int fq) {
  const f32x4 a = *(const f32x4*)(ssq + (size_t)row * 32 + fq * 8), b = *(const f32x4*)(ssq + (size_t)row * 32 + fq * 8 + 4);
  float sm = ((a[0] + a[1]) + (a[2] + a[3])) + ((b[0] + b[1]) + (b[2] + b[3]));
  sm += __shfl_xor(sm, 16); sm += __shfl_xor(sm, 32);
  return rsqrtf(sm * (1.0f / 2048.f) + 1e-6f);
}
struct EpiResid {
  static constexpr bool PERM = true;
  float* C; const float* base; bf16_t* xb; float* ssq;
  DI void operator()(const f32x4 (&acc)[2][2][4][2], const Unit& u, int wr, int wc, int fr, int fq) const {
    const int row0 = u.pm * BM + wr * 64 + fr, col0 = u.pn * BM + wc * 32 + 8 * fq;
#pragma unroll
    for (int ai = 0; ai < 2; ++ai) {
      f32x4 bv[4][2][2];
#pragma unroll
      for (int m = 0; m < 4; ++m)
#pragma unroll
        for (int bj = 0; bj < 2; ++bj) {
          const float* bp = base + (size_t)(row0 + ai * HALF + m * 16) * 2048 + col0 + bj * HALF;
          bv[m][bj][0] = *(const f32x4*)bp; bv[m][bj][1] = *(const f32x4*)(bp + 4);
        }
#pragma unroll
      for (int m = 0; m < 4; ++m) {
        const int row = row0 + ai * HALF + m * 16;
        const size_t off = (size_t)row * 2048 + col0;
        float ss = 0.f;
#pragma unroll
        for (int bj = 0; bj < 2; ++bj) {
          const f32x4 v0 = acc[ai][bj][m][0] + bv[m][bj][0], v1 = acc[ai][bj][m][1] + bv[m][bj][1];
          *(f32x4*)(C + off + bj * HALF) = v0; *(f32x4*)(C + off + bj * HALF + 4) = v1;
          if (xb) {
            u32x4 w; w.x = pack2(v0[0], v0[1]); w.y = pack2(v0[2], v0[3]); w.z = pack2(v1[0], v1[1]); w.w = pack2(v1[2], v1[3]);
            *(u32x4*)(xb + off + bj * HALF) = w;
            ss += v0[0] * v0[0] + v0[1] * v0[1] + v0[2] * v0[2] + v0[3] * v0[3] + v1[0] * v1[0] + v1[1] * v1[1] + v1[2] * v1[2] + v1[3] * v1[3];
          }
        }
        if (xb) {
          ss += __shfl_xor(ss, 16); ss += __shfl_xor(ss, 32);
          if (fq == 0) ssq[(size_t)row * 32 + u.pn * 4 + wc] = ss;
        }
      }
    }
  }
};
struct EpiBf16 {
  static constexpr bool PERM = true;
  bf16_t* O; int ldc; const float* ssq;
  DI void operator()(const f32x4 (&acc)[2][2][4][2], const Unit& u, int wr, int wc, int fr, int fq) const {
    const int row0 = u.pm * BM + wr * 64 + fr, col0 = u.pn * BM + wc * 32 + 8 * fq;
    float rsv[2][4];
#pragma unroll
    for (int ai = 0; ai < 2; ++ai)
#pragma unroll
      for (int m = 0; m < 4; ++m) rsv[ai][m] = row_rstd(ssq, row0 + ai * HALF + m * 16, fq);
#pragma unroll
    for (int ai = 0; ai < 2; ++ai)
#pragma unroll
      for (int m = 0; m < 4; ++m) {
        const int row = row0 + ai * HALF + m * 16;
        const float rs = rsv[ai][m];
        bf16_t* rowp = O + (size_t)row * ldc + col0;
#pragma unroll
        for (int bj = 0; bj < 2; ++bj) {
          const f32x4 v0 = acc[ai][bj][m][0] * rs, v1 = acc[ai][bj][m][1] * rs;
          u32x4 w; w.x = pack2(v0[0], v0[1]); w.y = pack2(v0[2], v0[3]); w.z = pack2(v1[0], v1[1]); w.w = pack2(v1[2], v1[3]);
          *(u32x4*)(rowp + bj * HALF) = w;
        }
      }
  }
};

DI float dpp_ror1(float v) { return __int_as_float(__builtin_amdgcn_update_dpp(0, __float_as_int(v), 0x121, 0xf, 0xf, false)); }
DI float dpp_ror2(float v) { return __int_as_float(__builtin_amdgcn_update_dpp(0, __float_as_int(v), 0x122, 0xf, 0xf, false)); }
struct EpiFfn {
  static constexpr bool PERM = true;
  bf16_t* H; const float* cw; const float* cb; float* tailG; float* headA; float* headU; const float* ssq;
  DI void operator()(const f32x4 (&acc)[2][2][4][2], const Unit& u, int wr, int wc, int fr, int fq) const {
    const int col = u.pn * 128 + wc * 32 + 8 * fq;
    float w0[8], w1[8], w2[8], bb[8];
#pragma unroll
    for (int e = 0; e < 8; ++e) { w0[e] = cw[col + e]; w1[e] = cw[5632 + col + e]; w2[e] = cw[2 * 5632 + col + e]; bb[e] = cb[col + e]; }
#pragma unroll
    for (int ai = 0; ai < 2; ++ai) {
      const int row0 = u.pm * BM + ai * HALF + wr * 64, span = row0 >> 6;
      float rsv[4];
#pragma unroll
      for (int m = 0; m < 4; ++m) rsv[m] = row_rstd(ssq, row0 + 16 * m + fr, fq);
      float p1[8], p2[8];
#pragma unroll
      for (int e = 0; e < 8; ++e) { p1[e] = 0.f; p2[e] = 0.f; }
#pragma unroll
      for (int m = 0; m < 4; ++m) {
        float g[8], uu[8], a[8];
        const float rs = rsv[m];
#pragma unroll
        for (int e = 0; e < 4; ++e) { g[e] = acc[ai][0][m][0][e] * rs; g[4 + e] = acc[ai][0][m][1][e] * rs; uu[e] = acc[ai][1][m][0][e] * rs; uu[4 + e] = acc[ai][1][m][1][e] * rs; }
#pragma unroll
        for (int e = 0; e < 8; ++e) {
          const float x1 = dpp_ror1(g[e]), x2 = dpp_ror2(g[e]);
          const float pr1 = (fr == 0) ? p1[e] : x1, pr2 = (fr < 2) ? p2[e] : x2;
          a[e] = w2[e] * g[e] + w1[e] * pr1 + w0[e] * pr2 + bb[e];
          p1[e] = x1; p2[e] = x2;
        }
        if (m == 0 && fr < 2) {
          float* ha = headA + (size_t)(span * 2 + fr) * 5632 + col; float* hu = headU + (size_t)(span * 2 + fr) * 5632 + col;
          *(f32x4*)ha = (f32x4){a[0], a[1], a[2], a[3]}; *(f32x4*)(ha + 4) = (f32x4){a[4], a[5], a[6], a[7]};
          *(f32x4*)hu = (f32x4){uu[0], uu[1], uu[2], uu[3]}; *(f32x4*)(hu + 4) = (f32x4){uu[4], uu[5], uu[6], uu[7]};
        } else {
          u32x4 w;
          w.x = pack2(silu_f(a[0]) * uu[0], silu_f(a[1]) * uu[1]);
          w.y = pack2(silu_f(a[2]) * uu[2], silu_f(a[3]) * uu[3]);
          w.z = pack2(silu_f(a[4]) * uu[4], silu_f(a[5]) * uu[5]);
          w.w = pack2(silu_f(a[6]) * uu[6], silu_f(a[7]) * uu[7]);
          *(u32x4*)(H + (size_t)(row0 + 16 * m + fr) * 5632 + col) = w;
        }
        if (m == 3 && fr >= 14) {
          float* tg = tailG + (size_t)(span * 2 + fr - 14) * 5632 + col;
          *(f32x4*)tg = (f32x4){g[0], g[1], g[2], g[3]}; *(f32x4*)(tg + 4) = (f32x4){g[4], g[5], g[6], g[7]};
        }
      }
    }
  }
};

struct EpiOdd {
  static constexpr bool PERM = true;
  bf16_t* BG; bf16_t* C; const float* cw; float* tailM; float* headC; const float* ssq;
  DI void operator()(const f32x4 (&acc)[2][2][4][2], const Unit& u, int wr, int wc, int fr, int fq) const {
    if (u.pn >= 16) {
      const int row0 = u.pm * BM + wr * 64 + fr, col0 = (u.pn - 16) * BM + wc * 32 + 8 * fq;
#pragma unroll
      for (int ai = 0; ai < 2; ++ai) {
#pragma unroll
        for (int mh = 0; mh < 2; ++mh) {
          u32x4 cw4[2][2];
          asm volatile("" ::: "memory");
#pragma unroll
          for (int mm = 0; mm < 2; ++mm) {
            const bf16_t* cp = C + (size_t)(row0 + ai * HALF + (2 * mh + mm) * 16) * 2048 + col0;
            cw4[mm][0] = *(const u32x4*)cp; cw4[mm][1] = *(const u32x4*)(cp + HALF);
          }
#pragma unroll
          for (int mm = 0; mm < 2; ++mm) {
            const int m = 2 * mh + mm;
            const bool head = (m == 0) && (fr < 2);
            bf16_t* rowp = BG + (size_t)(row0 + ai * HALF + m * 16) * 2048 + col0;
#pragma unroll
            for (int bj = 0; bj < 2; ++bj) {
              const u32x4 cw = cw4[mm][bj];
              const float c0 = head ? 1.f : lo_f(cw.x), c1 = head ? 1.f : hi_f(cw.x), c2 = head ? 1.f : lo_f(cw.y), c3 = head ? 1.f : hi_f(cw.y);
              const float c4 = head ? 1.f : lo_f(cw.z), c5 = head ? 1.f : hi_f(cw.z), c6 = head ? 1.f : lo_f(cw.w), c7 = head ? 1.f : hi_f(cw.w);
              const f32x4 v0 = acc[ai][bj][m][0], v1 = acc[ai][bj][m][1];
              u32x4 w; w.x = pack2(v0[0] * c0, v0[1] * c1); w.y = pack2(v0[2] * c2, v0[3] * c3); w.z = pack2(v1[0] * c4, v1[1] * c5); w.w = pack2(v1[2] * c6, v1[3] * c7);
              *(u32x4*)(rowp + bj * HALF) = w;
            }
          }
        }
      }
      return;
    }
    const int col = u.pn * 128 + wc * 32 + 8 * fq;
    float w0[8], w1[8], w2[8];
#pragma unroll
    for (int e = 0; e < 8; ++e) { w0[e] = cw[col + e]; w1[e] = cw[2048 + col + e]; w2[e] = cw[4096 + col + e]; }
#pragma unroll
    for (int ai = 0; ai < 2; ++ai) {
      const int row0 = u.pm * BM + ai * HALF + wr * 64, span = row0 >> 6;
      float rsv[4];
#pragma unroll
      for (int m = 0; m < 4; ++m) rsv[m] = row_rstd(ssq, row0 + 16 * m + fr, fq);
      float p1[8], p2[8];
#pragma unroll
      for (int e = 0; e < 8; ++e) { p1[e] = 0.f; p2[e] = 0.f; }
#pragma unroll
      for (int m = 0; m < 4; ++m) {
        float g[8], a[8];
        const float rs1 = rsv[m], rs2 = rs1 * rs1;
#pragma unroll
        for (int e = 0; e < 4; ++e) { g[e] = acc[ai][0][m][0][e] * acc[ai][1][m][0][e] * rs2; g[4 + e] = acc[ai][0][m][1][e] * acc[ai][1][m][1][e] * rs2; }
#pragma unroll
        for (int e = 0; e < 8; ++e) {
          const float x1 = dpp_ror1(g[e]), x2 = dpp_ror2(g[e]);
          const float pr1 = (fr == 0) ? p1[e] : x1, pr2 = (fr < 2) ? p2[e] : x2;
          a[e] = w2[e] * g[e] + w1[e] * pr1 + w0[e] * pr2;
          p1[e] = x1; p2[e] = x2;
        }
        if (m == 0 && fr < 2) {
          float* hc = headC + (size_t)(span * 2 + fr) * 2048 + col;
          *(f32x4*)hc = (f32x4){a[0], a[1], a[2], a[3]}; *(f32x4*)(hc + 4) = (f32x4){a[4], a[5], a[6], a[7]};
        } else {
          u32x4 w; w.x = pack2(a[0] * rs1, a[1] * rs1); w.y = pack2(a[2] * rs1, a[3] * rs1); w.z = pack2(a[4] * rs1, a[5] * rs1); w.w = pack2(a[6] * rs1, a[7] * rs1);
          *(u32x4*)(C + (size_t)(row0 + 16 * m + fr) * 2048 + col) = w;
        }
        if (m == 3 && fr >= 14) {
          float* tg = tailM + (size_t)(span * 2 + fr - 14) * 2048 + col;
          *(f32x4*)tg = (f32x4){g[0], g[1], g[2], g[3]}; *(f32x4*)(tg + 4) = (f32x4){g[4], g[5], g[6], g[7]};
        }
      }
    }
  }
};

template <class Epi, class Sched = StaticOrder>
DI void gemm_phase(LAS unsigned char* lds, const Gemm g, const Sched& S, const Epi& E) {
  const int tid = threadIdx.x, wid = __builtin_amdgcn_readfirstlane(tid >> 6), lane = tid & 63, wr = wid >> 2, wc = wid & 3, fr = lane & 15, fq = lane >> 4;
  const int K = g.K, nt = K / BK;
  unsigned voffA[2], voffB[2];
#pragma unroll
  for (int i = 0; i < 2; ++i) { int R, C; stage_rc(tid * 16 + i * 8192, R, C); const int Rb = Epi::PERM ? ((R & ~31) + perm32(R & 31)) : R;
    voffA[i] = (unsigned)(R * K + C) * 2u; voffB[i] = (unsigned)(Rb * K + C) * 2u; }
  const size_t kstep = (size_t)(BK * 2);
  const size_t hstep = (size_t)HALF * K * 2;
  const size_t tstep = 2 * hstep;
  const unsigned ldsw = (unsigned)wid * 1024u;
  const int aoff = lds_byte(wr * 64 + fr, fq * 8), boff = lds_byte(wc * 32 + fr, fq * 8);
#define PG8_SA(b, h) (((b) * 2 + (h)) * HTB)
#define PG8_SB(b, h) ((4 + (b) * 2 + (h)) * HTB)
#define PG8_STAGE(bufoff, gbase, voff) do { _Pragma("unroll") for (int _i = 0; _i < 2; ++_i) \
    __builtin_amdgcn_global_load_lds((const unsigned*)((const char*)(gbase) + (voff)[_i]), (LAS unsigned*)(lds + (bufoff) + ldsw + _i * 8192), 16, 0, 0); } while (0)
#define PG8_LDA(dst, b, h) do { _Pragma("unroll") for (int m = 0; m < 4; ++m) _Pragma("unroll") for (int k = 0; k < 2; ++k) dst[m][k] = *(const LAS bf16x8*)(lds + PG8_SA(b, h) + aoff + m * 2048 + k * 1024); } while (0)
#define PG8_LDB(dst, b, h) do { _Pragma("unroll") for (int n = 0; n < 2; ++n) _Pragma("unroll") for (int k = 0; k < 2; ++k) dst[n][k] = *(const LAS bf16x8*)(lds + PG8_SB(b, h) + boff + n * 2048 + k * 1024); } while (0)
#define PG8_MMA(ai, bj, At, Bt) do { __builtin_amdgcn_s_setprio(1); _Pragma("unroll") for (int m = 0; m < 4; ++m) _Pragma("unroll") for (int n = 0; n < 2; ++n) _Pragma("unroll") for (int k = 0; k < 2; ++k) \
    acc[ai][bj][m][n] = __builtin_amdgcn_mfma_f32_16x16x32_bf16(Bt[n][k], At[m][k], acc[ai][bj][m][n], 0, 0, 0); __builtin_amdgcn_s_setprio(0); } while (0)
#define PG8_WAIT_V(n) asm volatile("s_waitcnt vmcnt(" #n ")" ::: "memory")
#define PG8_WAIT_L(n) asm volatile("s_waitcnt lgkmcnt(" #n ")" ::: "memory")
#define PG8_BAR __builtin_amdgcn_s_barrier()
#define PG8_SCHED __builtin_amdgcn_sched_barrier(0)
  Unit cur, nxt; int ui = 0;
  if (!S.next(0, cur)) return;
  f32x4 acc[2][2][4][2];
#pragma unroll
  for (int a = 0; a < 2; ++a)
#pragma unroll
    for (int b = 0; b < 2; ++b)
#pragma unroll
      for (int m = 0; m < 4; ++m)
#pragma unroll
        for (int n = 0; n < 2; ++n) acc[a][b][m][n] = (f32x4){0.f, 0.f, 0.f, 0.f};
  bf16x8 At[4][2], B0[2][2], B1[2][2];
  const char* cA = (const char*)g.A + (size_t)cur.pm * tstep; const char* cB = (const char*)g.Bt + (size_t)cur.pn * tstep;
  PG8_STAGE(PG8_SB(0, 0), cB, voffB); PG8_STAGE(PG8_SA(0, 0), cA, voffA); PG8_STAGE(PG8_SB(0, 1), cB + hstep, voffB); PG8_STAGE(PG8_SA(0, 1), cA + hstep, voffA);
  if (wr == 1) PG8_BAR;
  PG8_WAIT_V(4); PG8_BAR;
  PG8_STAGE(PG8_SB(1, 0), cB + kstep, voffB); PG8_STAGE(PG8_SA(1, 0), cA + kstep, voffA); PG8_STAGE(PG8_SB(1, 1), cB + hstep + kstep, voffB);
  PG8_WAIT_V(6); PG8_BAR;
  for (;;) {
    const bool has_next = S.next(ui + 1, nxt);
    const char* nA = has_next ? (const char*)g.A + (size_t)nxt.pm * tstep : cA; const char* nB = has_next ? (const char*)g.Bt + (size_t)nxt.pn * tstep : cB;
    for (int t = 0; t < nt; t += 2) {
      const bool last = (t == nt - 2);
      const char* a1 = cA + (size_t)(t + 1) * kstep;
      const char* a2 = last ? nA : cA + (size_t)(t + 2) * kstep; const char* b2 = last ? nB : cB + (size_t)(t + 2) * kstep;
      const char* a3 = a2 + kstep; const char* b3 = b2 + kstep;
      PG8_LDB(B0, 0, 0); PG8_SCHED; PG8_LDA(At, 0, 0); PG8_STAGE(PG8_SA(1, 1), a1 + hstep, voffA);
      PG8_WAIT_L(8); PG8_BAR; PG8_WAIT_L(0); PG8_MMA(0, 0, At, B0); PG8_BAR; PG8_SCHED;
      PG8_LDB(B1, 0, 1); PG8_STAGE(PG8_SB(0, 0), b2, voffB);
      PG8_BAR; PG8_WAIT_L(0); PG8_MMA(0, 1, At, B1); PG8_BAR;
      PG8_LDA(At, 0, 1); PG8_STAGE(PG8_SA(0, 0), a2, voffA);
      PG8_BAR; PG8_WAIT_L(0); PG8_MMA(1, 0, At, B0); PG8_BAR; PG8_SCHED;
      PG8_STAGE(PG8_SB(0, 1), b2 + hstep, voffB);
      PG8_WAIT_V(6); PG8_BAR; PG8_MMA(1, 1, At, B1); PG8_BAR;
      PG8_LDB(B0, 1, 0); PG8_SCHED; PG8_LDA(At, 1, 0); PG8_STAGE(PG8_SA(0, 1), a2 + hstep, voffA);
      PG8_WAIT_L(8); PG8_BAR; PG8_WAIT_L(0); PG8_MMA(0, 0, At, B0); PG8_BAR; PG8_SCHED;
      PG8_LDB(B1, 1, 1); PG8_STAGE(PG8_SB(1, 0), b3, voffB);
      PG8_BAR; PG8_WAIT_L(0); PG8_MMA(0, 1, At, B1); PG8_BAR;
      PG8_LDA(At, 1, 1); PG8_STAGE(PG8_SA(1, 0), a3, voffA);
      PG8_BAR; PG8_WAIT_L(0); PG8_MMA(1, 0, At, B0); PG8_BAR; PG8_SCHED;
      PG8_STAGE(PG8_SB(1, 1), b3 + hstep, voffB);
      PG8_WAIT_V(6); PG8_BAR; PG8_MMA(1, 1, At, B1); PG8_BAR;
    }
    E(acc, cur, wr, wc, fr, fq);
    if (!has_next) break;
#pragma unroll
    for (int a = 0; a < 2; ++a)
#pragma unroll
      for (int b = 0; b < 2; ++b)
#pragma unroll
        for (int m = 0; m < 4; ++m)
#pragma unroll
          for (int n = 0; n < 2; ++n) acc[a][b][m][n] = (f32x4){0.f, 0.f, 0.f, 0.f};
    cur = nxt; cA = nA; cB = nB; ++ui;
  }
  PG8_WAIT_V(0);
  if (wr == 0) PG8_BAR;
  PG8_BAR;
#undef PG8_SA
#undef PG8_SB
#undef PG8_STAGE
#undef PG8_LDA
#undef PG8_LDB
#undef PG8_MMA
#undef PG8_WAIT_V
#undef PG8_WAIT_L
#undef PG8_BAR
#undef PG8_SCHED
}
}

struct CJob { const float* src; bf16_t* dst; int K, N, Nout, kind; const float* gain; };
DI CJob get_job(const Params& p, int j) {
  CJob c;
  switch (j) {
    case 0: c = {p.ev_w_in, ((bf16_t*)(p.ws + OFF_wt_ev_in)), 2048, 4632, 4864, 1, p.ev_norm}; break;
    case 1: c = {p.ev_w_out, ((bf16_t*)(p.ws + OFF_wt_ev_out)), 2048, 2048, 2048, 0, nullptr}; break;
    case 2: c = {p.ffn_w_in, ((bf16_t*)(p.ws + OFF_wt_ffn_in)), 2048, NFF2, NFF2, 2, p.ffn_norm}; break;
    case 3: c = {p.ffn_w_in + (size_t)2048 * NFF2, ((bf16_t*)(p.ws + OFF_wt_ffn_in)) + (size_t)NFF2 * 2048, 2048, NFF2, NFF2, 2, p.ffn_norm + 2048}; break;
    case 4: c = {p.ffn_w_down, ((bf16_t*)(p.ws + OFF_wt_ffn_dn)), DFF, 2048, 2048, 0, nullptr}; break;
    case 5: c = {p.ffn_w_down + (size_t)DFF * 2048, ((bf16_t*)(p.ws + OFF_wt_ffn_dn)) + (size_t)2048 * DFF, DFF, 2048, 2048, 0, nullptr}; break;
    case 6: c = {p.od_w_in, ((bf16_t*)(p.ws + OFF_wt_od_in)), 2048, 6144, 6144, 3, p.od_norm}; break;
    case 7: c = {p.od_w_out, ((bf16_t*)(p.ws + OFF_wt_od_out)), 2048, 2048, 2048, 0, nullptr}; break;
    case 8: c = {p.ev_cmp_k_w1, ((bf16_t*)(p.ws + OFF_w1t_k)), 4096, 128, 128, 0, nullptr}; break;
    default: c = {p.ev_cmp_v_w1, ((bf16_t*)(p.ws + OFF_w1t_v)), 4096, 128, 128, 0, nullptr}; break;
  }
  return c;
}
DI int map_col(int kind, int n) {
  if (kind == 0) return n;
  if (kind == 1) return n < 2560 ? n : (n < 4608 ? n + 24 : (n < 4632 ? n - 2048 : -1));
  const int T = n >> 8, c = n & 255;
  if (kind == 3) return T < 16 ? (c < 128 ? 2048 + 128 * T + c : 4096 + 128 * T + (c - 128)) : 256 * (T - 16) + c;
  return c < 128 ? 128 * T + c : DFF + 128 * T + (c - 128);
}
DI void conv_phase(const Params& p, unsigned char* smem) {
  float* tile = (float*)smem;
  const int tid = threadIdx.x;
  int cum = 0;
  for (int j = 0; j < 10; ++j) {
    const CJob jb = get_job(p, j);
    const int ntn = jb.Nout / 256, ngroups = (jb.K / 64) * ntn;
    const int G_ = (int)gridDim.x, first = ((int)blockIdx.x - (cum % G_) + G_) % G_;
    cum += (ntn == 0) ? jb.K / 64 : ngroups;
    const bool has_gain = jb.gain != nullptr;
    const float* gp = has_gain ? jb.gain : p.ev_norm;
    if (ntn == 0) {
      for (int t = first; t < jb.K / 64; t += gridDim.x) {
        const int k0 = t * 64, nn = tid & 63, kk0 = tid >> 6;
        float lv[2][8];
#pragma unroll
        for (int q = 0; q < 2; ++q)
#pragma unroll
          for (int i = 0; i < 8; ++i) lv[q][i] = jb.src[(size_t)(k0 + kk0 + 8 * i) * jb.N + q * 64 + nn];
#pragma unroll
        for (int q = 0; q < 2; ++q)
#pragma unroll
          for (int i = 0; i < 8; ++i) tile[q * 4160 + (kk0 + 8 * i) * 65 + nn] = lv[q][i];
        __syncthreads();
        const int n = tid >> 3, kc = tid & 7;
#pragma unroll
        for (int q = 0; q < 2; ++q) {
          float v[8];
#pragma unroll
          for (int e = 0; e < 8; ++e) v[e] = tile[q * 4160 + (kc * 8 + e) * 65 + n];
          u32x4 w; w.x = pack2(v[0], v[1]); w.y = pack2(v[2], v[3]); w.z = pack2(v[4], v[5]); w.w = pack2(v[6], v[7]);
          const int e = q * 64 + n, kk = k0 + kc * 8;
          *(u32x4*)(jb.dst + ((size_t)(((kk >> 4) * 4 + (e >> 5)) * 64 + (kc & 1) * 32 + (e & 31))) * 8) = w;
        }
        __syncthreads();
      }
      continue;
    }
    {
      const int nn = tid & 63, kk0 = tid >> 6, n = tid >> 3, kc = tid & 7;
      float lv[4][8]; int scq[4];
      int t = first;
      if (t < ngroups) {
        const int k0 = (t / ntn) * 64, n0 = (t % ntn) * 256;
#pragma unroll
        for (int q = 0; q < 4; ++q) {
          scq[q] = map_col(jb.kind, n0 + q * 64 + nn);
          const float* sp = jb.src + (size_t)(k0 + kk0) * jb.N + (scq[q] >= 0 ? scq[q] : 0);
#pragma unroll
          for (int i = 0; i < 8; ++i) lv[q][i] = __builtin_nontemporal_load(sp + (size_t)(8 * i) * jb.N);
        }
      }
      for (; t < ngroups; t += gridDim.x) {
        const int k0 = (t / ntn) * 64, n0 = (t % ntn) * 256;
        const f32x4 ga = *(const f32x4*)(gp + (has_gain ? k0 + kc * 8 : 0)), gb = *(const f32x4*)(gp + (has_gain ? k0 + kc * 8 + 4 : 0));
#pragma unroll
        for (int q = 0; q < 4; ++q)
#pragma unroll
          for (int i = 0; i < 8; ++i) tile[q * 4160 + (kk0 + 8 * i) * 65 + nn] = scq[q] >= 0 ? lv[q][i] : 0.f;
        __syncthreads();
        const int tn = t + gridDim.x;
        if (tn < ngroups) {
          const int k1 = (tn / ntn) * 64, n1 = (tn % ntn) * 256;
#pragma unroll
          for (int q = 0; q < 4; ++q) {
            scq[q] = map_col(jb.kind, n1 + q * 64 + nn);
            const float* sp = jb.src + (size_t)(k1 + kk0) * jb.N + (scq[q] >= 0 ? scq[q] : 0);
#pragma unroll
            for (int i = 0; i < 8; ++i) lv[q][i] = __builtin_nontemporal_load(sp + (size_t)(8 * i) * jb.N);
          }
        }
#pragma unroll
        for (int q = 0; q < 4; ++q) {
          float v[8];
#pragma unroll
          for (int e = 0; e < 8; ++e) v[e] = tile[q * 4160 + (kc * 8 + e) * 65 + n];
          if (has_gain) { v[0] *= ga[0]; v[1] *= ga[1]; v[2] *= ga[2]; v[3] *= ga[3]; v[4] *= gb[0]; v[5] *= gb[1]; v[6] *= gb[2]; v[7] *= gb[3]; }
          u32x4 w; w.x = pack2(v[0], v[1]); w.y = pack2(v[2], v[3]); w.z = pack2(v[4], v[5]); w.w = pack2(v[6], v[7]);
          __builtin_nontemporal_store(w, (u32x4*)(jb.dst + (size_t)(n0 + q * 64 + n) * jb.K + k0 + kc * 8));
        }
        __syncthreads();
      }
    }
  }
}

DI void cast_phase(const float* X, bf16_t* out, float* ssq) {
  const int wid = threadIdx.x >> 6, lane = threadIdx.x & 63;
  for (int row = blockIdx.x * 8 + wid; row < NTOK; row += gridDim.x * 8) {
    const f32x4* xr = (const f32x4*)(X + (size_t)row * DM);
    f32x4 v[8]; float ss = 0.f;
#pragma unroll
    for (int i = 0; i < 8; ++i) { v[i] = __builtin_nontemporal_load(xr + lane + 64 * i); ss += v[i][0] * v[i][0] + v[i][1] * v[i][1] + v[i][2] * v[i][2] + v[i][3] * v[i][3]; }
#pragma unroll
    for (int o = 1; o < 64; o <<= 1) ss += __shfl_xor(ss, o);
    if (lane < 32) ssq[(size_t)row * 32 + lane] = lane == 0 ? ss : 0.f;
#pragma unroll
    for (int i = 0; i < 8; ++i) {
      u32x2 w; w.x = pack2(v[i][0], v[i][1]); w.y = pack2(v[i][2], v[i][3]);
      *(u32x2*)(out + (size_t)row * DM + (lane + 64 * i) * 4) = w;
    }
  }
}

DI void unpack8(const u32x4 w, float (&f)[8]) { f[0] = lo_f(w.x); f[1] = hi_f(w.x); f[2] = lo_f(w.y); f[3] = hi_f(w.y); f[4] = lo_f(w.z); f[5] = hi_f(w.z); f[6] = lo_f(w.w); f[7] = hi_f(w.w); }
DI u32x4 pack8(const float (&f)[8]) { u32x4 w; w.x = pack2(f[0], f[1]); w.y = pack2(f[2], f[3]); w.z = pack2(f[4], f[5]); w.w = pack2(f[6], f[7]); return w; }

DI void ffn_fixup(const Params& p, const float* cw) {
  for (unsigned idx = blockIdx.x * 512 + threadIdx.x; idx < 256u * 2u * 1408u; idx += gridDim.x * 512) {
    const int c4 = idx % 1408, jr = (idx / 1408) & 1, sp = idx / 2816, col = c4 * 4;
    f32x4 a = *(const f32x4*)(((float*)(p.ws + OFF_headA)) + (size_t)(sp * 2 + jr) * DFF + col);
    const f32x4 uu = *(const f32x4*)(((float*)(p.ws + OFF_headU)) + (size_t)(sp * 2 + jr) * DFF + col);
    if (sp & 63) {
      const f32x4 g1 = *(const f32x4*)(((float*)(p.ws + OFF_tailG)) + (size_t)((sp - 1) * 2 + 1) * DFF + col), g2 = *(const f32x4*)(((float*)(p.ws + OFF_tailG)) + (size_t)((sp - 1) * 2) * DFF + col);
      const f32x4 w0 = *(const f32x4*)(cw + col), w1 = *(const f32x4*)(cw + DFF + col);
      if (jr == 0) a += w1 * g1 + w0 * g2; else a += w0 * g1;
    }
    u32x2 w; w.x = pack2(silu_f(a[0]) * uu[0], silu_f(a[1]) * uu[1]); w.y = pack2(silu_f(a[2]) * uu[2], silu_f(a[3]) * uu[3]);
    *(u32x2*)(((bf16_t*)(p.ws + OFF_H)) + (size_t)(sp * 64 + jr) * DFF + col) = w;
  }
}
DI void ew_odd(const Params& p) {
  const float* cw = p.od_conv_w;
  const unsigned stride = gridDim.x * 512u;
  for (unsigned idx = blockIdx.x * 512 + threadIdx.x; idx < 512u * 256u; idx += stride) {
    const int hr = idx >> 8, j0 = (idx & 255) * 8, sp = hr >> 1, lr = hr & 1, r = sp * 64 + lr;
    float bg[8], c[8], o[8];
    unpack8(*(const u32x4*)(((bf16_t*)(p.ws + OFF_A6)) + (size_t)r * DM + j0), bg);
    const float* hc = ((float*)(p.ws + OFF_headC)) + (size_t)hr * DM + j0;
    const f32x4 ca = *(const f32x4*)hc, cb = *(const f32x4*)(hc + 4);
    const int spp = (sp & 63) ? sp - 1 : sp;
    const float* t1 = ((float*)(p.ws + OFF_tailM)) + (size_t)(spp * 2 + 1) * DM + j0; const float* t0 = ((float*)(p.ws + OFF_tailM)) + (size_t)(spp * 2) * DM + j0;
    const f32x4 t1a = *(const f32x4*)t1, t1b = *(const f32x4*)(t1 + 4), t0a = *(const f32x4*)t0, t0b = *(const f32x4*)(t0 + 4);
    const f32x4 w0a = *(const f32x4*)(cw + j0), w0b = *(const f32x4*)(cw + j0 + 4), w1a = *(const f32x4*)(cw + 2048 + j0), w1b = *(const f32x4*)(cw + 2048 + j0 + 4);
    const float on = (sp & 63) ? 1.0f : 0.0f;
#pragma unroll
    for (int e = 0; e < 4; ++e) {
      const float xa = (lr == 0) ? (w1a[e] * t1a[e] + w0a[e] * t0a[e]) : (w0a[e] * t1a[e]);
      const float xb = (lr == 0) ? (w1b[e] * t1b[e] + w0b[e] * t0b[e]) : (w0b[e] * t1b[e]);
      c[e] = ca[e] + on * xa; c[4 + e] = cb[e] + on * xb;
    }
    const float* sq = ((float*)(p.ws + OFF_ssq)) + (size_t)2 * NTOK * 32 + (size_t)r * 32;
    float sm = 0.f;
#pragma unroll
    for (int e = 0; e < 8; ++e) { const f32x4 q4 = *(const f32x4*)(sq + 4 * e); sm += (q4[0] + q4[1]) + (q4[2] + q4[3]); }
    const float rs = rsqrtf(sm * (1.0f / 2048.f) + EPSF);
#pragma unroll
    for (int e = 0; e < 8; ++e) o[e] = bg[e] * rs * c[e];
    *(u32x4*)(((bf16_t*)(p.ws + OFF_A6)) + (size_t)r * DM + j0) = pack8(o);
  }
}

DI void prep_tokens(const Params& p) {
  const int wid = threadIdx.x >> 6, lane = threadIdx.x & 63;
  const bool bal = gridDim.x == 256;
  const int ntk = bal ? (blockIdx.x < 128 ? 4 : 12) : (NTOK - ((int)blockIdx.x * 8 + wid) + (int)gridDim.x * 8 - 1) / ((int)gridDim.x * 8);
  for (int ti = 0; ti < ntk; ++ti) {
    const int tok = bal ? (blockIdx.x < 128 ? (int)blockIdx.x * 32 + wid * 4 + ti : 4096 + ((int)blockIdx.x - 128) * 96 + wid * 12 + ti)
                        : (int)blockIdx.x * 8 + wid + ti * (int)gridDim.x * 8;
    const bf16_t* pr = ((bf16_t*)(p.ws + OFF_P)) + (size_t)tok * LDP;
    {
      float v[16]; float a[8], b[8];
      unpack8(*(const u32x4*)(pr + lane * 16), a); unpack8(*(const u32x4*)(pr + lane * 16 + 8), b);
      float ss = 0.f;
#pragma unroll
      for (int e = 0; e < 8; ++e) { v[e] = a[e]; v[8 + e] = b[e]; ss += a[e] * a[e] + b[e] * b[e]; }
      ss += __shfl_xor(ss, 1); ss += __shfl_xor(ss, 2); ss += __shfl_xor(ss, 4);
      const float rs = rsqrtf(ss * (1.0f / 128.f) + EPSF) * (0.08838834764831845f * 1.4426950408889634f);
      const int d0 = (lane * 16) & 127;
#pragma unroll
      for (int e = 0; e < 8; ++e) { a[e] = v[e] * rs * p.ev_q_gain[d0 + e]; b[e] = v[8 + e] * rs * p.ev_q_gain[d0 + 8 + e]; }
      *(u32x4*)(((bf16_t*)(p.ws + OFF_qn)) + (size_t)tok * 1024 + lane * 16) = pack8(a);
      *(u32x4*)(((bf16_t*)(p.ws + OFF_qn)) + (size_t)tok * 1024 + lane * 16 + 8) = pack8(b);
    }
    const int bb = tok >> 12, s = tok & 4095, g = lane >> 5, d0 = (lane * 4) & 127;
#pragma unroll
    for (int which = 0; which < 2; ++which) {
      const u32x2 w = *(const u32x2*)(pr + (which ? 2048 : 1536) + lane * 4);
      const float v0 = lo_f(w.x), v1 = hi_f(w.x), v2 = lo_f(w.y), v3 = hi_f(w.y);
      float ss = v0 * v0 + v1 * v1 + v2 * v2 + v3 * v3;
#pragma unroll
      for (int o = 1; o < 32; o <<= 1) ss += __shfl_xor(ss, o);
      const float rs = rsqrtf(ss * (1.0f / 128.f) + EPSF);
      const float* kg = p.ev_k_gain + (which ? 256 : 128) + d0;
      u32x2 o2; o2.x = pack2(v0 * rs * kg[0], v1 * rs * kg[1]); o2.y = pack2(v2 * rs * kg[2], v3 * rs * kg[3]);
      bf16_t* dst = (which ? ((bf16_t*)(p.ws + OFF_kwn)) : ((bf16_t*)(p.ws + OFF_ksn))) + ((size_t)(bb * 2 + g) * SEQ + s) * 128 + d0;
      *(u32x2*)dst = o2;
    }
  }
}
DI void prep_vtrans(const Params& p, unsigned char* smem) {
  bf16_t* tl = (bf16_t*)smem;
  const int tid = threadIdx.x;
  const bool bal = gridDim.x == 256;
  const int nit = bal ? (blockIdx.x < 128 ? 0 : 8) : (1024 - (int)blockIdx.x + (int)gridDim.x - 1) / (int)gridDim.x;
  for (int k = 0; k < nit; ++k) {
    const int it = bal ? ((int)blockIdx.x - 128) * 8 + k : (int)blockIdx.x + k * (int)gridDim.x;
    const int st = it & 63, g = (it >> 6) & 1, bb = (it >> 7) & 3, which = it >> 9;
    const int colbase = (which ? 2304 : 1792) + g * 128;
#pragma unroll
    for (int i = 0; i < 2; ++i) { const int c = tid + 512 * i, row = c >> 4, c16 = c & 15;
      *(u32x4*)(tl + row * 136 + c16 * 8) = *(const u32x4*)(((bf16_t*)(p.ws + OFF_P)) + (size_t)(bb * SEQ + st * 64 + row) * LDP + colbase + c16 * 8); }
    __syncthreads();
    const int d = tid >> 2, chk = tid & 3;
    float a[8], b[8];
#pragma unroll
    for (int e = 0; e < 8; ++e) { a[e] = bf2f(tl[(chk * 16 + e) * 136 + d]); b[e] = bf2f(tl[(chk * 16 + 8 + e) * 136 + d]); }
    bf16_t* dst = (which ? ((bf16_t*)(p.ws + OFF_vwT)) : ((bf16_t*)(p.ws + OFF_vsT))) + ((size_t)(bb * 2 + g) * 128 + d) * SEQ + st * 64 + chk * 16;
    *(u32x4*)dst = pack8(a); *(u32x4*)(dst + 8) = pack8(b);
    __syncthreads();
  }
}
DI void prep_compress(const Params& p, unsigned char* smem) {
  float* part = (float*)smem;
  float* hid = (float*)(smem + 65536);
  const int tid = threadIdx.x, wid = tid >> 6, lane = tid & 63, r = lane & 31, h = lane >> 5;
  for (int it = blockIdx.x; it < 128; it += gridDim.x) {
    const int nt = it & 7, g = (it >> 3) & 1, bb = (it >> 4) & 3, which = it >> 6;
    const bf16_t* w1t = which ? ((bf16_t*)(p.ws + OFF_w1t_v)) : ((bf16_t*)(p.ws + OFF_w1t_k));
    const float* w2 = which ? p.ev_cmp_v_w2 : p.ev_cmp_k_w2;
    const int n = nt * 32 + r; const bool nvalid = n < 255;
    const int colbase = (which ? 1280 : 1024) + g * 128;
    f32x16 acc[4];
#pragma unroll
    for (int e = 0; e < 4; ++e)
#pragma unroll
      for (int i = 0; i < 16; ++i) acc[e][i] = 0.f;
#pragma unroll 8
    for (int st = wid * 32; st < wid * 32 + 32; ++st) {
      const int l = st >> 3, d = ((st & 7) << 4) + 8 * h;
      bf16x8 af;
      {
        float a[8];
        const int tok = nvalid ? 16 * n + l : 0;
        unpack8(*(const u32x4*)(((bf16_t*)(p.ws + OFF_P)) + (size_t)(bb * SEQ + tok) * LDP + colbase + d), a);
        const float* pe = p.ev_cmp_pe + l * 128 + d;
#pragma unroll
        for (int e = 0; e < 8; ++e) a[e] = nvalid ? a[e] + pe[e] : 0.f;
        af = __builtin_bit_cast(bf16x8, pack8(a));
      }
#pragma unroll
      for (int et = 0; et < 4; ++et) {
        const bf16x8 bf = *(const bf16x8*)(w1t + ((size_t)((st * 4 + et) * 64 + h * 32 + r)) * 8);
        acc[et] = MFMA32(af, bf, acc[et]);
      }
    }
    if (wid >= 4) {
#pragma unroll
      for (int et = 0; et < 4; ++et)
#pragma unroll
        for (int i = 0; i < 16; ++i) part[((wid - 4) * 32 + ((i & 3) + 8 * (i >> 2) + 4 * h)) * 128 + 32 * et + r] = acc[et][i];
    }
    __syncthreads();
    if (wid < 4) {
#pragma unroll
      for (int et = 0; et < 4; ++et)
#pragma unroll
        for (int i = 0; i < 16; ++i) { float* q = &part[(wid * 32 + ((i & 3) + 8 * (i >> 2) + 4 * h)) * 128 + 32 * et + r]; *q = *q + acc[et][i]; }
    }
    __syncthreads();
    for (int i = tid; i < 4096; i += 512) hid[i] = gelu_tanh((part[i] + part[4096 + i]) + (part[8192 + i] + part[12288 + i]));
    __syncthreads();
    {
      const int nl = tid >> 4, f0 = (tid & 15) * 8;
      float o[8];
#pragma unroll
      for (int e = 0; e < 8; ++e) o[e] = 0.f;
#pragma unroll 16
      for (int e = 0; e < 128; ++e) {
        const float hv = hid[nl * 128 + e];
        const f32x4 wa = *(const f32x4*)(w2 + e * 128 + f0), wb = *(const f32x4*)(w2 + e * 128 + f0 + 4);
        o[0] += hv * wa[0]; o[1] += hv * wa[1]; o[2] += hv * wa[2]; o[3] += hv * wa[3];
        o[4] += hv * wb[0]; o[5] += hv * wb[1]; o[6] += hv * wb[2]; o[7] += hv * wb[3];
      }
      const int ng = nt * 32 + nl;
      if (which == 0) {
        float ss = 0.f;
#pragma unroll
        for (int e = 0; e < 8; ++e) ss += o[e] * o[e];
        ss += __shfl_xor(ss, 1); ss += __shfl_xor(ss, 2); ss += __shfl_xor(ss, 4); ss += __shfl_xor(ss, 8);
        const float rs = rsqrtf(ss * (1.0f / 128.f) + EPSF);
#pragma unroll
        for (int e = 0; e < 8; ++e) o[e] = ng < 255 ? o[e] * rs * p.ev_k_gain[f0 + e] : 0.f;
        *(u32x4*)(((bf16_t*)(p.ws + OFF_kcn)) + ((size_t)(bb * 2 + g) * 256 + ng) * 128 + f0) = pack8(o);
      } else {
#pragma unroll
        for (int e = 0; e < 8; ++e) ((bf16_t*)(p.ws + OFF_vcT))[((size_t)(bb * 2 + g) * 128 + f0 + e) * 256 + ng] = (bf16_t)(pack2(ng < 255 ? o[e] : 0.f, 0.f) & 0xffffu);
      }
    }
    __syncthreads();
  }
}
DI void prep_gmlp(const Params& p, unsigned char* smem) {
  bf16_t* VT = (bf16_t*)smem;
  const int tid = threadIdx.x, wid = tid >> 6, lane = tid & 63, r = lane & 31, h = lane >> 5;
  const bool bal = gridDim.x == 256;
  const int nmine = bal ? (blockIdx.x < 128 ? 2 : 6) : (1024 - (int)blockIdx.x + (int)gridDim.x - 1) / (int)gridDim.x;
  for (int k = 0; k < nmine; ++k) {
    const int it = bal ? (blockIdx.x < 128 ? (int)blockIdx.x + 128 * k : 256 + ((int)blockIdx.x - 128) * 6 + k) : (int)blockIdx.x + k * (int)gridDim.x;
    const int g = it & 7, c = (it >> 3) & 31, bb = it >> 8;
    const size_t T0 = (size_t)bb * SEQ + c * 128;
    const int ti = wid >> 1, dh = wid & 1, t = 32 * ti + r, nst = 2 * (ti + 1);
    const float* wrow = p.ev_gmlp_ws + ((size_t)g * 128 + t) * 128;
    f32x4 wv[8][2];
#pragma unroll
    for (int st = 0; st < 8; ++st) {
      if (st < nst) { wv[st][0] = *(const f32x4*)(wrow + 16 * st + 8 * h); wv[st][1] = *(const f32x4*)(wrow + 16 * st + 8 * h + 4); }
      else { wv[st][0] = (f32x4){0.f, 0.f, 0.f, 0.f}; wv[st][1] = (f32x4){0.f, 0.f, 0.f, 0.f}; }
    }
    {
      const int tt = tid >> 2, qd = tid & 3;
      const bf16_t* src = ((bf16_t*)(p.ws + OFF_P)) + (T0 + tt) * LDP + 3584 + g * 128 + 32 * qd;
      float z[32];
#pragma unroll
      for (int i = 0; i < 4; ++i) { float a[8]; unpack8(*(const u32x4*)(src + 8 * i), a);
#pragma unroll
        for (int e = 0; e < 8; ++e) z[8 * i + e] = gelu_tanh(a[e]); }
      float sm = 0.f;
#pragma unroll
      for (int e = 0; e < 32; ++e) sm += z[e];
      sm += __shfl_xor(sm, 1); sm += __shfl_xor(sm, 2);
      const float mean = sm * (1.0f / 128.f);
      float sv = 0.f;
#pragma unroll
      for (int e = 0; e < 32; ++e) { z[e] -= mean; sv += z[e] * z[e]; }
      sv += __shfl_xor(sv, 1); sv += __shfl_xor(sv, 2);
      const float rs = rsqrtf(sv * (1.0f / 128.f) + EPSF);
      const float* gn = p.ev_gmlp_norm + g * 128 + 32 * qd;
#pragma unroll
      for (int e = 0; e < 32; e += 2) { const unsigned w = pack2(z[e] * rs * gn[e], z[e + 1] * rs * gn[e + 1]);
        VT[(32 * qd + e) * 136 + tt] = (bf16_t)(w & 0xffffu); VT[(32 * qd + e + 1) * 136 + tt] = (bf16_t)(w >> 16); }
    }
    __syncthreads();
    {
      f32x16 acc[2];
#pragma unroll
      for (int e = 0; e < 2; ++e)
#pragma unroll
        for (int i = 0; i < 16; ++i) acc[e][i] = 0.f;
#pragma unroll
      for (int st = 0; st < 8; ++st) {
        if (st < nst) {
          const int s0 = 16 * st + 8 * h;
          float a[8] = {wv[st][0][0], wv[st][0][1], wv[st][0][2], wv[st][0][3], wv[st][1][0], wv[st][1][1], wv[st][1][2], wv[st][1][3]};
#pragma unroll
          for (int e = 0; e < 8; ++e) a[e] = (s0 + e <= t) ? a[e] : 0.f;
          const bf16x8 af = __builtin_bit_cast(bf16x8, pack8(a));
#pragma unroll
          for (int e = 0; e < 2; ++e) {
            const bf16x8 bf = *(const bf16x8*)(VT + (32 * (2 * dh + e) + r) * 136 + s0);
            acc[e] = MFMA32(af, bf, acc[e]);
          }
        }
      }
#pragma unroll
      for (int e = 0; e < 2; ++e)
#pragma unroll
        for (int i = 0; i < 16; ++i) {
          const int to = 32 * ti + (i & 3) + 8 * (i >> 2) + 4 * h, d = 32 * (2 * dh + e) + r;
          const float u = gelu_tanh(bf2f(((bf16_t*)(p.ws + OFF_P))[(T0 + to) * LDP + 2560 + g * 128 + d]));
          const float o = u * (acc[e][i] + p.ev_gmlp_b[g * 128 + to]);
          ((bf16_t*)(p.ws + OFF_omix))[(T0 + to) * DM + 1024 + g * 128 + d] = (bf16_t)(pack2(o, 0.f) & 0xffffu);
        }
    }
    __syncthreads();
  }
}

struct AttnCtx {
  const bf16_t* Kg; const bf16_t* Vg; int vstride;
};
DI void stage_load(const AttnCtx& c, int key0, u32x4 (&kr)[2], u32x4 (&vr)[2]) {
  const int tid = threadIdx.x;
#pragma unroll
  for (int i = 0; i < 2; ++i) { const int ch = tid + 512 * i;
    kr[i] = *(const u32x4*)(c.Kg + (size_t)key0 * 128 + ch * 8);
    vr[i] = *(const u32x4*)(c.Vg + (size_t)(ch >> 3) * c.vstride + key0 + (ch & 7) * 8); }
}
DI void stage_store(unsigned char* Kt, unsigned char* Vt, const u32x4 (&kr)[2], const u32x4 (&vr)[2]) {
  const int tid = threadIdx.x;
#pragma unroll
  for (int i = 0; i < 2; ++i) { const int ch = tid + 512 * i;
    *(u32x4*)(Kt + (ch >> 4) * 272 + (ch & 15) * 16) = kr[i];
    unsigned char* vp = Vt + (ch >> 3) * 136 + (ch & 7) * 16;
    *(u32x2*)vp = (u32x2){vr[i].x, vr[i].y}; *(u32x2*)(vp + 8) = (u32x2){vr[i].z, vr[i].w}; }
}

template <int MODE>
DI void attn_branch(const AttnCtx& c, unsigned long long tmask, unsigned char* Kb, unsigned char* Vb, int& cur, const bf16x8 (&qf)[8],
                    f32x16 (&o)[4], float& m, float& l, float inv_l, int pos, unsigned long long mysel, float* imp, int pl, int hr, int r, int h, int qb, unsigned long long tmask2 = 0ull) {
  u32x4 kr[2], vr[2];
  int j = __builtin_ctzll(tmask);
  stage_load(c, 64 * j, kr, vr);
  float carry = 0.f;
  for (;;) {
    cur ^= 1;
    unsigned char* Kt = Kb + cur * 17408; unsigned char* Vt = Vb + cur * 17408;
    stage_store(Kt, Vt, kr, vr);
    __syncthreads();
    tmask &= tmask - 1;
    if (tmask == 0ull) { tmask = tmask2; tmask2 = 0ull; }
    const bool more = tmask != 0ull;
    int jn = 0;
    if (more) { jn = __builtin_ctzll(tmask); stage_load(c, 64 * jn, kr, vr); }
    f32x16 s0, s1;
#pragma unroll
    for (int i = 0; i < 16; ++i) { s0[i] = 0.f; s1[i] = 0.f; }
#pragma unroll
    for (int st = 0; st < 8; ++st) {
      const bf16x8 k0 = *(const bf16x8*)(Kt + r * 272 + st * 32 + h * 16);
      const bf16x8 k1 = *(const bf16x8*)(Kt + (32 + r) * 272 + st * 32 + h * 16);
      s0 = MFMA32(k0, qf[st], s0); s1 = MFMA32(k1, qf[st], s1);
    }
    int hi, lo = -100000;
    if (MODE <= 1) hi = ((pos - 31) >> 4) - 64 * j;
    else if (MODE == 2) hi = ((mysel >> j) & 1ull) ? pos - 64 * j : -1;
    else { hi = pos - 64 * j; lo = pos - 511 - 64 * j; }
    hi -= 4 * h; lo -= 4 * h;
    float pv0[16], pv1[16];
    if (MODE == 1) {
#pragma unroll
      for (int i = 0; i < 16; ++i) {
        const int kc = (i & 3) + 8 * (i >> 2);
        pv0[i] = (kc <= hi && kc >= lo) ? __builtin_amdgcn_exp2f(s0[i] - m) * inv_l : 0.f;
        pv1[i] = (kc + 32 <= hi && kc + 32 >= lo) ? __builtin_amdgcn_exp2f(s1[i] - m) * inv_l : 0.f;
      }
#pragma unroll
      for (int u = 0; u < 2; ++u)
#pragma unroll
        for (int a = 0; a < 4; ++a) {
          const float p0 = u ? pv1[4 * a] : pv0[4 * a], p1 = u ? pv1[4 * a + 1] : pv0[4 * a + 1], p2 = u ? pv1[4 * a + 2] : pv0[4 * a + 2], p3 = u ? pv1[4 * a + 3] : pv0[4 * a + 3];
          const float p3o = __shfl_xor(p3, 32);
          float val = ((p0 + p1) + (p2 + p3)) + (h ? p3o : carry);
          carry = p3o;
          val += __shfl_xor(val, 1); val += __shfl_xor(val, 2);
          if (hr == 0) imp[pl * 65 + 16 * j + 8 * u + 2 * a + h] = val;
        }
    } else {
      const bool slow = (MODE == 0) || (j == qb) || (MODE == 3 && qb >= 8 && j == qb - 8);
      const bool lane_on = (MODE == 2) ? (((mysel >> j) & 1ull) != 0ull) : true;
      const float ninf = -__builtin_inff();
      if (slow) {
        asm volatile("" : "+v"(hi), "+v"(lo));
#pragma unroll
        for (int i = 0; i < 16; ++i) {
          const int kc = (i & 3) + 8 * (i >> 2);
          s0[i] = (kc <= hi && kc >= lo) ? s0[i] : ninf;
          s1[i] = (kc + 32 <= hi && kc + 32 >= lo) ? s1[i] : ninf;
        }
      }
      float tmax = ninf;
#pragma unroll
      for (int i = 0; i < 16; ++i) { tmax = __builtin_amdgcn_fmed3f(tmax, s0[i], __builtin_inff()); tmax = __builtin_amdgcn_fmed3f(tmax, s1[i], __builtin_inff()); }
      tmax = lane_on ? tmax : ninf;
      tmax = fmaxf(tmax, __shfl_xor(tmax, 32));
      const bool need = (MODE == 0) ? (tmax > m) : (tmax > m + 8.0f);
      if (__builtin_amdgcn_ballot_w64(need) != 0ull) {
        asm volatile("" ::);
        const float mn = need ? tmax : m;
        const float alpha = __builtin_amdgcn_exp2f(m - mn);
        m = mn; l *= alpha;
        if (MODE != 0) {
#pragma unroll
          for (int dt = 0; dt < 4; ++dt)
#pragma unroll
            for (int i = 0; i < 16; ++i) o[dt][i] *= alpha;
        }
      }
      const float meff = lane_on ? m : __builtin_inff();
      float ps = 0.f;
#pragma unroll
      for (int i = 0; i < 16; ++i) {
        pv0[i] = __builtin_amdgcn_exp2f(s0[i] - meff);
        pv1[i] = __builtin_amdgcn_exp2f(s1[i] - meff);
        ps += pv0[i] + pv1[i];
      }
      l += ps;
    }
    if (MODE != 0) {
#pragma unroll
      for (int u = 0; u < 2; ++u)
#pragma unroll
        for (int s = 0; s < 2; ++s) {
          u32x4 pw;
          if (u == 0) { pw.x = pack2(pv0[8 * s], pv0[8 * s + 1]); pw.y = pack2(pv0[8 * s + 2], pv0[8 * s + 3]); pw.z = pack2(pv0[8 * s + 4], pv0[8 * s + 5]); pw.w = pack2(pv0[8 * s + 6], pv0[8 * s + 7]); }
          else { pw.x = pack2(pv1[8 * s], pv1[8 * s + 1]); pw.y = pack2(pv1[8 * s + 2], pv1[8 * s + 3]); pw.z = pack2(pv1[8 * s + 4], pv1[8 * s + 5]); pw.w = pack2(pv1[8 * s + 6], pv1[8 * s + 7]); }
          const bf16x8 pf = __builtin_bit_cast(bf16x8, pw);
#pragma unroll
          for (int dt = 0; dt < 4; ++dt) {
            const unsigned char* vp = Vt + (32 * dt + r) * 136 + (32 * u + 16 * s + 4 * h) * 2;
            const u32x2 va = *(const u32x2*)vp, vb = *(const u32x2*)(vp + 16);
            const bf16x8 vf = __builtin_bit_cast(bf16x8, (u32x4){va.x, va.y, vb.x, vb.y});
            o[dt] = MFMA32(vf, pf, o[dt]);
          }
        }
    }
    if (!more) break;
    j = jn;
  }
}

DI void attn_phase(const Params& p, unsigned char* smem) {
  unsigned char* Kb = smem;
  unsigned char* Vb = smem + 34816;
  float* imp = (float*)(smem + 69632);
  unsigned* selw = (unsigned*)(smem + 69632 + 16640);
  unsigned* uni = selw + 128;
  const int tid = threadIdx.x, wid = tid >> 6, lane = tid & 63, r = lane & 31, h = lane >> 5;
  int cur = 0;
  for (int it = blockIdx.x; it < 512; it += gridDim.x) {
    const int pi = it & 255, bg = pi & 7, qi = pi >> 3;
    const int qb = (it < 256) ? 63 - qi : qi;
    const int bb = bg >> 1, g = bg & 1;
    const int q0 = qb * 64, pl = wid * 8 + (r >> 2), pos = q0 + pl, hr = r & 3, head = g * 4 + hr;
    const size_t token = (size_t)bb * SEQ + pos;
    bf16x8 qf[8];
    {
      const bf16_t* qp = ((bf16_t*)(p.ws + OFF_qn)) + token * 1024 + head * 128 + 8 * h;
#pragma unroll
      for (int st = 0; st < 8; ++st) qf[st] = *(const bf16x8*)(qp + 16 * st);
    }
    for (int i = tid; i < 64 * 65; i += 512) imp[i] = 0.f;
    f32x16 o[4];
    const size_t kvh = (size_t)(bb * 2 + g);
    {
      AttnCtx c; c.Kg = ((bf16_t*)(p.ws + OFF_kcn)) + kvh * 256 * 128; c.Vg = ((bf16_t*)(p.ws + OFF_vcT)) + kvh * 128 * 256; c.vstride = 256;
      const int nmax = (q0 + 32) >> 4;
      const int ntl = min(4, (nmax >> 6) + 1);
      const unsigned long long tm = (1ull << ntl) - 1ull;
      float m = NEGF, l = 0.f;
      attn_branch<0>(c, tm, Kb, Vb, cur, qf, o, m, l, 0.f, pos, 0ull, imp, pl, hr, r, h, qb);
      const float lt = l + __shfl_xor(l, 32);
      const float inv_l = lt > 0.f ? 1.0f / lt : 0.f;
#pragma unroll
      for (int dt = 0; dt < 4; ++dt)
#pragma unroll
        for (int i = 0; i < 16; ++i) o[dt][i] = 0.f;
      attn_branch<1>(c, tm, Kb, Vb, cur, qf, o, m, l, inv_l, pos, 0ull, imp, pl, hr, r, h, qb);
      int tk_ = (int)token; asm volatile("" : "+v"(tk_));
      const bf16_t* glp = ((bf16_t*)(p.ws + OFF_P)) + (size_t)tk_ * LDP + 4608 + head * 3;
      float* orow = ((float*)(p.ws + OFF_oacc)) + (size_t)tk_ * 1024 + head * 128;
      const float gate0 = sigmoid_f(bf2f(glp[0]));
#pragma unroll
      for (int dt = 0; dt < 4; ++dt)
#pragma unroll
        for (int a = 0; a < 4; ++a) {
          f32x4 v = {o[dt][4 * a] * gate0, o[dt][4 * a + 1] * gate0, o[dt][4 * a + 2] * gate0, o[dt][4 * a + 3] * gate0};
          *(f32x4*)(orow + 32 * dt + 8 * a + 4 * h) = v;
        }
    }
    __syncthreads();
    unsigned long long mysel, usel;
    {
      const int ps = tid >> 3, sub = tid & 7;
      unsigned* ikey = (unsigned*)imp;
      unsigned bits = 0;
      if (qb < 16) {
#pragma unroll
        for (int jj = 0; jj < 8; ++jj) bits |= ((sub * 8 + jj) <= qb) ? (1u << jj) : 0u;
        __syncthreads();
      } else {
        unsigned v[8];
#pragma unroll
        for (int jj = 0; jj < 8; ++jj) {
          const int j = sub * 8 + jj;
          const float x = imp[ps * 65 + j];
          const bool forced = (j == 0) || (j == qb) || (j == qb - 1);
          v[jj] = forced ? 0xffffffffu : (j <= qb ? __float_as_uint(fmaxf(x, 0.f)) : 0u);
        }
#pragma unroll
        for (int jj = 0; jj < 8; ++jj) ikey[ps * 65 + sub * 8 + jj] = v[jj];
        __syncthreads();
        int cnt[8];
#pragma unroll
        for (int jj = 0; jj < 8; ++jj) cnt[jj] = 0;
        for (int j2 = 0; j2 < sub * 8; ++j2) {
          const unsigned y = ikey[ps * 65 + j2];
#pragma unroll
          for (int jj = 0; jj < 8; ++jj) cnt[jj] += (y >= v[jj]) ? 1 : 0;
        }
#pragma unroll
        for (int j2 = 0; j2 < 8; ++j2) {
          const unsigned y = ikey[ps * 65 + sub * 8 + j2];
#pragma unroll
          for (int jj = 0; jj < 8; ++jj) cnt[jj] += (y > v[jj] || (y == v[jj] && j2 < jj)) ? 1 : 0;
        }
        for (int j2 = sub * 8 + 8; j2 < 64; ++j2) {
          const unsigned y = ikey[ps * 65 + j2];
#pragma unroll
          for (int jj = 0; jj < 8; ++jj) cnt[jj] += (y > v[jj]) ? 1 : 0;
        }
#pragma unroll
        for (int jj = 0; jj < 8; ++jj) bits |= (cnt[jj] < 16 && (sub * 8 + jj) <= qb) ? (1u << jj) : 0u;
      }
      unsigned w = bits << (8 * (sub & 3));
      w |= __shfl_xor(w, 1); w |= __shfl_xor(w, 2);
      if ((sub & 3) == 0) selw[ps * 2 + (sub >> 2)] = w;
      __syncthreads();
      if (tid < 64) {
        unsigned a = selw[tid * 2], b = selw[tid * 2 + 1];
#pragma unroll
        for (int of = 1; of < 64; of <<= 1) { a |= __shfl_xor(a, of); b |= __shfl_xor(b, of); }
        if (tid == 0) { uni[0] = a; uni[1] = b; }
      }
      __syncthreads();
      usel = (unsigned long long)uni[0] | ((unsigned long long)uni[1] << 32);
      mysel = (unsigned long long)selw[pl * 2] | ((unsigned long long)selw[pl * 2 + 1] << 32);
    }
    {
      AttnCtx c; c.Kg = ((bf16_t*)(p.ws + OFF_ksn)) + kvh * SEQ * 128; c.Vg = ((bf16_t*)(p.ws + OFF_vsT)) + kvh * 128 * SEQ; c.vstride = SEQ;
      float m = NEGF, l = 0.f;
#pragma unroll
      for (int dt = 0; dt < 4; ++dt)
#pragma unroll
        for (int i = 0; i < 16; ++i) o[dt][i] = 0.f;
      const int rot = (qi * 5) % (qb + 1);
      const unsigned long long lo_m = usel & ((1ull << rot) - 1ull), hi_m = usel & ~((1ull << rot) - 1ull);
      attn_branch<2>(c, hi_m ? hi_m : lo_m, Kb, Vb, cur, qf, o, m, l, 0.f, pos, mysel, imp, pl, hr, r, h, qb, hi_m ? lo_m : 0ull);
      const float lt = l + __shfl_xor(l, 32);
      int tk_ = (int)token; asm volatile("" : "+v"(tk_));
      const bf16_t* glp = ((bf16_t*)(p.ws + OFF_P)) + (size_t)tk_ * LDP + 4608 + head * 3;
      float* orow = ((float*)(p.ws + OFF_oacc)) + (size_t)tk_ * 1024 + head * 128;
      const float sc = sigmoid_f(bf2f(glp[1])) / lt;
#pragma unroll
      for (int dt = 0; dt < 4; ++dt)
#pragma unroll
        for (int a = 0; a < 4; ++a) {
          float* q = orow + 32 * dt + 8 * a + 4 * h;
          f32x4 v = *(const f32x4*)q;
          v[0] += o[dt][4 * a] * sc; v[1] += o[dt][4 * a + 1] * sc; v[2] += o[dt][4 * a + 2] * sc; v[3] += o[dt][4 * a + 3] * sc;
          *(f32x4*)q = v;
        }
    }
    {
      AttnCtx c; c.Kg = ((bf16_t*)(p.ws + OFF_kwn)) + kvh * SEQ * 128; c.Vg = ((bf16_t*)(p.ws + OFF_vwT)) + kvh * 128 * SEQ; c.vstride = SEQ;
      const int tlo = qb >= 8 ? qb - 8 : 0;
      const unsigned long long tm = (qb == 63 ? ~0ull : ((1ull << (qb + 1)) - 1ull)) & ~((1ull << tlo) - 1ull);
      float m = NEGF, l = 0.f;
#pragma unroll
      for (int dt = 0; dt < 4; ++dt)
#pragma unroll
        for (int i = 0; i < 16; ++i) o[dt][i] = 0.f;
      attn_branch<3>(c, tm, Kb, Vb, cur, qf, o, m, l, 0.f, pos, 0ull, imp, pl, hr, r, h, qb);
      const float lt = l + __shfl_xor(l, 32);
      int tk_ = (int)token; asm volatile("" : "+v"(tk_));
      const bf16_t* glp = ((bf16_t*)(p.ws + OFF_P)) + (size_t)tk_ * LDP + 4608 + head * 3;
      float* orow = ((float*)(p.ws + OFF_oacc)) + (size_t)tk_ * 1024 + head * 128;
      const float sc = sigmoid_f(bf2f(glp[2])) / lt;
      bf16_t* om = ((bf16_t*)(p.ws + OFF_omix)) + token * DM + head * 128;
#pragma unroll
      for (int dt = 0; dt < 4; ++dt)
#pragma unroll
        for (int a = 0; a < 4; ++a) {
          const float* q = orow + 32 * dt + 8 * a + 4 * h;
          f32x4 v = *(const f32x4*)q;
          v[0] += o[dt][4 * a] * sc; v[1] += o[dt][4 * a + 1] * sc; v[2] += o[dt][4 * a + 2] * sc; v[3] += o[dt][4 * a + 3] * sc;
          u32x2 w; w.x = pack2(v[0], v[1]); w.y = pack2(v[2], v[3]);
          *(u32x2*)(om + 32 * dt + 8 * a + 4 * h) = w;
        }
    }
    __syncthreads();
  }
}


#define XB_TMO      128
#define XB_XCNT(j)  (256  + 64 * (j))
#define XB_XSUB(j)  (1280 + 64 * (j))
#define XB_XGEN(j)  (2304 + 64 * (j))
#define XB_TOP      3328
#define XB_TOPGEN   3392
#define XCD_BAR_WORDS 3456
#define XB_SPIN_CAP (1u << 20)
__device__ unsigned g_bar_words[3456];
DI unsigned xb_ld(unsigned* p) { return __hip_atomic_load(p, __ATOMIC_RELAXED, __HIP_MEMORY_SCOPE_AGENT); }
DI unsigned xb_add(unsigned* p, unsigned v) { return __hip_atomic_fetch_add(p, v, __ATOMIC_RELAXED, __HIP_MEMORY_SCOPE_AGENT); }
DI unsigned xb_xcc_id() { return (unsigned)__builtin_amdgcn_s_getreg((3 << 11) | 20) & 0xFu; }
#define XB_SPIN(cond, bar) do { unsigned _sp = 0; while (cond) { __builtin_amdgcn_s_sleep(1); \
    if ((++_sp & 255u) == 0u) { if (xb_ld(&(bar)[XB_TMO])) break; if (_sp > XB_SPIN_CAP) { atomicAdd(&(bar)[XB_TMO], 1u); break; } } } } while (0)
struct XcdBarrier { unsigned* bar; unsigned x; volatile LAS unsigned* st; };
DI XcdBarrier xcd_barrier_post(unsigned* bar, volatile LAS unsigned* st) {
  XcdBarrier b; b.bar = bar; b.x = xb_xcc_id(); b.st = st;
  if (threadIdx.x == 0) {
    __hip_atomic_store(&bar[XB_TMO], 0u, __ATOMIC_RELAXED, __HIP_MEMORY_SCOPE_AGENT);
    const unsigned raw = xb_add(&bar[XB_XCNT(b.x)], 1u);
    const bool mono = gridDim.x == 256u;
    const unsigned slot = mono ? (raw & 31u) : raw;
    st[3] = mono ? (raw >> 5) : 0u;
    st[2] = (mono && b.x < 8u) ? slot * 8u + b.x : blockIdx.x;
  }
  return b;
}
DI void xcd_barrier_complete(unsigned* bar, unsigned x, unsigned k, unsigned& nloc, unsigned& nx) {
  const unsigned G = gridDim.x * gridDim.y * gridDim.z;
  unsigned sum, cnt, mine, sp = 0u;
  for (;;) {
    sum = 0u; cnt = 0u; mine = 0u;
#pragma unroll
    for (unsigned j = 0; j < 16; ++j) { const unsigned c = xb_ld(&bar[XB_XCNT(j)]); sum += c; cnt += (c > 0u) ? 1u : 0u; mine = (j == x) ? c : mine; }
    if (sum == G * (k + 1u)) break;
    __builtin_amdgcn_s_sleep(1);
    if ((++sp & 255u) == 0u) { if (xb_ld(&bar[XB_TMO])) break; if (sp > XB_SPIN_CAP) { atomicAdd(&bar[XB_TMO], 1u); break; } }
  }
  mine -= 32u * k;
  nloc = mine > 0u ? mine : 1u; nx = cnt > 0u ? cnt : 1u;
}
DI void xcd_barrier(const XcdBarrier& b) {
  asm volatile("s_waitcnt vmcnt(0)" ::: "memory");
  __syncthreads();
  if (threadIdx.x == 0) {
    unsigned* bar = b.bar;
    __builtin_amdgcn_s_waitcnt(0);
    unsigned nloc = b.st[0], nx = b.st[1];
    if (nloc == 0u) { xcd_barrier_complete(bar, b.x, b.st[3], nloc, nx); b.st[0] = nloc; b.st[1] = nx; }
    const unsigned old = xb_add(&bar[XB_XSUB(b.x)], 1u);
    const unsigned gen = old / nloc;
    if (old + 1u == (gen + 1u) * nloc) {
      __builtin_amdgcn_fence(__ATOMIC_RELEASE, "agent");
      asm volatile("s_waitcnt vmcnt(0)" ::: "memory");
      const unsigned og = xb_add(&bar[XB_TOP], 1u);
      const unsigned tg = og / nx;
      if (og + 1u == (tg + 1u) * nx) xb_add(&bar[XB_TOPGEN], 1u);
      else XB_SPIN(xb_ld(&bar[XB_TOPGEN]) == tg, bar);
      __builtin_amdgcn_fence(__ATOMIC_ACQUIRE, "agent");
      xb_add(&bar[XB_XGEN(b.x)], 1u);
      asm volatile("s_waitcnt vmcnt(0)" ::: "memory");
    } else {
      XB_SPIN(xb_ld(&bar[XB_XGEN(b.x)]) == gen, bar);
      __builtin_amdgcn_fence(__ATOMIC_ACQUIRE, "agent");
      asm volatile("s_waitcnt vmcnt(0)" ::: "memory");
    }
  }
  __syncthreads();
}

DI void mk_barrier(unsigned* bar, unsigned char* smem) {
  XcdBarrier b; b.bar = bar; b.x = xb_xcc_id(); b.st = (volatile LAS unsigned*)(LAS unsigned char*)(smem + 131072);
  xcd_barrier(b);
}

DI void run_gemm(const Params& p, int id, unsigned char* smem) {
  pg8::Gemm g; pg8::StaticOrder S;
  bf16_t* ob = nullptr; int ldc = 0; const float* base = nullptr; int kind = 0;
  const float* cw = nullptr; const float* cb = nullptr; const float* ssq_in = nullptr; float* ssq_out = nullptr; bf16_t* xbo = ((bf16_t*)(p.ws + OFF_xb));
  switch (id) {
    case 0: g = {((bf16_t*)(p.ws + OFF_xb)), ((bf16_t*)(p.ws + OFF_wt_ev_in)), NTOK, LDP, DM}; ob = ((bf16_t*)(p.ws + OFF_P)); ldc = LDP; ssq_in = ((float*)(p.ws + OFF_ssq)); break;
    case 1: g = {((bf16_t*)(p.ws + OFF_omix)), ((bf16_t*)(p.ws + OFF_wt_ev_out)), NTOK, DM, DM}; kind = 1; base = p.x; ssq_out = ((float*)(p.ws + OFF_ssq)) + (size_t)NTOK * 32; break;
    case 2: g = {((bf16_t*)(p.ws + OFF_xb)), ((bf16_t*)(p.ws + OFF_wt_ffn_in)), NTOK, NFF2, DM}; kind = 2; cw = p.ffn_conv_w; cb = p.ffn_conv_b; ssq_in = ((float*)(p.ws + OFF_ssq)) + (size_t)NTOK * 32; break;
    case 4: g = {((bf16_t*)(p.ws + OFF_H)), ((bf16_t*)(p.ws + OFF_wt_ffn_dn)), NTOK, DM, DFF}; kind = 1; base = p.out; ssq_out = ((float*)(p.ws + OFF_ssq)) + (size_t)2 * NTOK * 32; break;
    case 5: g = {((bf16_t*)(p.ws + OFF_xb)), ((bf16_t*)(p.ws + OFF_wt_od_in)), NTOK, 6144, DM}; kind = 3; ssq_in = ((float*)(p.ws + OFF_ssq)) + (size_t)2 * NTOK * 32; break;
    case 6: g = {((bf16_t*)(p.ws + OFF_A6)), ((bf16_t*)(p.ws + OFF_wt_od_out)), NTOK, DM, DM}; kind = 1; base = p.out; ssq_out = ((float*)(p.ws + OFF_ssq)) + (size_t)3 * NTOK * 32; break;
    case 7: g = {((bf16_t*)(p.ws + OFF_xb)), ((bf16_t*)(p.ws + OFF_wt_ffn_in)) + (size_t)NFF2 * DM, NTOK, NFF2, DM}; kind = 2; cw = p.ffn_conv_w + 3 * DFF; cb = p.ffn_conv_b + DFF; ssq_in = ((float*)(p.ws + OFF_ssq)) + (size_t)3 * NTOK * 32; break;
    default: g = {((bf16_t*)(p.ws + OFF_H)), ((bf16_t*)(p.ws + OFF_wt_ffn_dn)) + (size_t)DM * DFF, NTOK, DM, DFF}; kind = 1; base = p.out; xbo = nullptr; break;
  }
  S.init(g.M, g.N, (int)gridDim.x, __builtin_amdgcn_readfirstlane((int)((volatile LAS unsigned*)(LAS unsigned char*)(smem + 131072))[2]));
  if (kind == 1) { pg8::EpiResid E; E.C = p.out; E.base = base; E.xb = xbo; E.ssq = ssq_out; pg8::gemm_phase<pg8::EpiResid>((LAS unsigned char*)smem, g, S, E); }
  else if (kind == 2) { pg8::EpiFfn E; E.H = ((bf16_t*)(p.ws + OFF_H)); E.cw = cw; E.cb = cb; E.tailG = ((float*)(p.ws + OFF_tailG)); E.headA = ((float*)(p.ws + OFF_headA)); E.headU = ((float*)(p.ws + OFF_headU)); E.ssq = ssq_in; pg8::gemm_phase<pg8::EpiFfn>((LAS unsigned char*)smem, g, S, E); }
  else if (kind == 3) { pg8::EpiOdd E; E.BG = ((bf16_t*)(p.ws + OFF_A6)); E.C = ((bf16_t*)(p.ws + OFF_Cc)); E.cw = p.od_conv_w; E.tailM = ((float*)(p.ws + OFF_tailM)); E.headC = ((float*)(p.ws + OFF_headC)); E.ssq = ssq_in; pg8::TripletOrder T; T.init((int)gridDim.x, S.c); pg8::gemm_phase<pg8::EpiOdd, pg8::TripletOrder>((LAS unsigned char*)smem, g, T, E); }
  else { pg8::EpiBf16 E; E.O = ob; E.ldc = ldc; E.ssq = ssq_in; pg8::gemm_phase<pg8::EpiBf16>((LAS unsigned char*)smem, g, S, E); }
}

#ifndef PROBE_DUP
#define PROBE_DUP -1
#endif
#define PHASE(k, body) if (p.phase_lo <= (k) && (k) < p.phase_hi) { if ((k) > p.phase_lo) { mk_barrier(gridDim.x == 256u ? g_bar_words : ((unsigned*)(p.ws + OFF_bar)), smem); } body; if ((k) == PROBE_DUP) { mk_barrier(gridDim.x == 256u ? g_bar_words : ((unsigned*)(p.ws + OFF_bar)), smem); body; } }
__global__ __launch_bounds__(512) void mega(Params p) {
  extern __shared__ __attribute__((aligned(16))) unsigned char smem[];
  cg::grid_group grid = cg::this_grid();
  volatile LAS unsigned* xst = (volatile LAS unsigned*)(LAS unsigned char*)(smem + 131072);
  if (threadIdx.x == 0) { xst[0] = 0u; xst[1] = 0u; }
  __syncthreads();
  (void)xcd_barrier_post(gridDim.x == 256u ? g_bar_words : ((unsigned*)(p.ws + OFF_bar)), xst);
  __syncthreads();
  if (p.phase_hi > 1000) grid.sync();
  PHASE(0, conv_phase(p, smem); cast_phase(p.x, ((bf16_t*)(p.ws + OFF_xb)), ((float*)(p.ws + OFF_ssq))))
  PHASE(1, run_gemm(p, 0, smem))
  PHASE(2, prep_compress(p, smem); prep_tokens(p); prep_vtrans(p, smem); prep_gmlp(p, smem))
  PHASE(3, attn_phase(p, smem))
  PHASE(4, run_gemm(p, 1, smem))
  PHASE(5, run_gemm(p, 2, smem))
  PHASE(6, ffn_fixup(p, p.ffn_conv_w))
  PHASE(7, run_gemm(p, 4, smem))
  PHASE(8, run_gemm(p, 5, smem))
  PHASE(9, ew_odd(p))
  PHASE(10, run_gemm(p, 6, smem))
  PHASE(11, run_gemm(p, 7, smem))
  PHASE(12, ffn_fixup(p, p.ffn_conv_w + 3 * DFF))
  PHASE(13, run_gemm(p, 9, smem))
}

extern "C" void kernel_launch(void* const* d_in, const int* in_sizes, int n_in, void* d_out, int out_size, void* d_ws, size_t ws_size, hipStream_t stream) {
  Params p{};
  const float* const* in = (const float* const*)d_in;
  p.x = in[0]; p.ev_norm = in[1]; p.ev_w_in = in[2]; p.ev_q_gain = in[3]; p.ev_k_gain = in[4]; p.ev_cmp_pe = in[5]; p.ev_cmp_k_w1 = in[6]; p.ev_cmp_k_w2 = in[7];
  p.ev_cmp_v_w1 = in[8]; p.ev_cmp_v_w2 = in[9]; p.ev_gmlp_norm = in[10]; p.ev_gmlp_ws = in[11]; p.ev_gmlp_b = in[12]; p.ev_w_out = in[13]; p.od_norm = in[14];
  p.od_w_in = in[15]; p.od_conv_w = in[16]; p.od_w_out = in[17]; p.ffn_norm = in[18]; p.ffn_w_in = in[19]; p.ffn_conv_w = in[20]; p.ffn_conv_b = in[21]; p.ffn_w_down = in[22];
  p.out = (float*)d_out;
  p.ws = (unsigned char*)d_ws;
  if (WS_NEED > ws_size) { fprintf(stderr, "workspace too small: need %zu have %zu\n", (size_t)WS_NEED, ws_size); return; }

  static int grid_blocks = 0;
  if (!grid_blocks) {
    hipFuncSetAttribute((const void*)mega, hipFuncAttributeMaxDynamicSharedMemorySize, LDS_BYTES);
    int dev = 0, cus = 0, per_cu = 0;
    hipGetDevice(&dev);
    hipDeviceGetAttribute(&cus, hipDeviceAttributeMultiprocessorCount, dev);
    hipOccupancyMaxActiveBlocksPerMultiprocessor(&per_cu, mega, 512, LDS_BYTES);
    if (per_cu < 1) per_cu = 1;
    grid_blocks = cus * per_cu;
  }
  if (grid_blocks != 256) (void)hipMemsetAsync(p.ws + OFF_bar, 0, (size_t)XCD_BAR_WORDS * 4, stream);
#if MULTI_LAUNCH
  for (int ph = 0; ph < NPHASE; ++ph) {
    p.phase_lo = ph; p.phase_hi = ph + 1;
    hipLaunchKernelGGL(mega, dim3(grid_blocks), dim3(512), LDS_BYTES, stream, p);
  }
#else
  p.phase_lo = 0; p.phase_hi = NPHASE;
  void* args[] = {&p};
  hipError_t e = hipLaunchCooperativeKernel((void*)mega, dim3(grid_blocks), dim3(512), args, LDS_BYTES, stream);
  if (e != hipSuccess) fprintf(stderr, "cooperative launch failed: %s (grid %d)\n", hipGetErrorString(e), grid_blocks);
#endif
}
```
